# Optimizing an MI355X kernel written in HIP

```python
import jax, jax.numpy as jnp
from jax import lax
import numpy as np

D_MODEL = 1024
BATCH = 4
SEQ = 8192
DEPTH = 1

GRID_W = 64
CTX_LEN = 256
HGRN_HEADS = 4
HGRN_DK = 128
HGRN_DV = 128
HGRN_WIDTH = HGRN_HEADS * HGRN_DK
HGRN_CHUNK = 64
SGU_GROUPS = 4
SGU_CHUNK = 128
SGU_WIDTH = 512
SGU_GROUP_DIM = SGU_WIDTH // SGU_GROUPS
ROWS_PER_SGU_CHUNK = SGU_CHUNK // GRID_W
N_EXPERTS = 16
EXPERT_FF = 2048
CAPACITY_FACTOR = 2
N_MOD = 6
EPS = 1e-6
IN_COLS = 5 * HGRN_WIDTH + 2 * SGU_WIDTH + 2 * D_MODEL

kernel_name = 'hybrid_hgrn2_sgu_ecmoe_dit_layer'


def rmsnorm(x, w):
    xf = x.astype(jnp.float32)
    y = xf * lax.rsqrt(jnp.mean(xf * xf, axis=-1, keepdims=True) + EPS)
    return (y * w.astype(jnp.float32)).astype(x.dtype)


def adaln(cond, w, b):
    m = jax.nn.silu(cond) @ w + b
    m = m.reshape((-1, 1, N_MOD * D_MODEL))
    return jnp.split(m, N_MOD, axis=-1)


def modulate(h, shift, scale):
    return h * (1 + scale) + shift


def split_in(p):
    sizes = (HGRN_WIDTH,) * 5 + (SGU_WIDTH,) * 2 + (D_MODEL,) * 2
    idx = []
    acc = 0
    for s in sizes[:-1]:
        acc += s
        idx.append(acc)
    return jnp.split(p, idx, axis=-1)


def to_heads(a):
    return a.reshape(a.shape[0], a.shape[1], HGRN_HEADS, HGRN_DK)


def hgrn_forget(z, lb):
    f = lb + (1 - lb) * jax.nn.sigmoid(z.astype(jnp.float32))
    return jnp.log(f), 1 - f


def hgrn_chunk_scan(q, k, logf, v, s0):
    B_, T, H, DK = q.shape
    DV = v.shape[-1]
    nc = T // HGRN_CHUNK

    def to_chunks(a):
        return a.astype(jnp.float32).reshape(B_, nc, HGRN_CHUNK, H, a.shape[-1]).transpose(1, 0, 3, 2, 4)

    qc, kc, fc, vc = to_chunks(q), to_chunks(k), to_chunks(logf), to_chunks(v)
    mask = jnp.tril(jnp.ones((HGRN_CHUNK, HGRN_CHUNK), dtype=bool))[None, None, :, :, None]

    def step(S, inp):
        qb, kb, fb, vb = inp
        b = jnp.cumsum(fb, axis=2)
        diff = b[:, :, :, None, :] - b[:, :, None, :, :]
        decay = jnp.exp(jnp.where(mask, diff, -jnp.inf))
        scores = jnp.einsum('bhik,bhijk->bhij', qb, decay * kb[:, :, None, :, :])
        o = jnp.einsum('bhij,bhjv->bhiv', scores, vb) + jnp.einsum('bhik,bhkv->bhiv', qb * jnp.exp(b), S)
        b_last = b[:, :, -1:, :]
        S_new = jnp.exp(b_last[:, :, 0, :])[..., None] * S + jnp.einsum('bhjk,bhjv->bhkv', kb * jnp.exp(b_last - b), vb)
        return S_new, o

    s_fin, o = lax.scan(step, s0.astype(jnp.float32), (qc, kc, fc, vc))
    o = o.transpose(1, 0, 3, 2, 4).reshape(B_, T, H, DV)
    return o, s_fin


def hgrn_final_state(k, logf, v):
    b = jnp.cumsum(logf.astype(jnp.float32), axis=1)
    w = k.astype(jnp.float32) * jnp.exp(b[:, -1:] - b)
    return jnp.einsum('bthk,bthv->bhkv', w, v.astype(jnp.float32))


def sgu(u, v, norm_w, w_s, b_s, n_chunks):
    B_, T, _ = u.shape
    u = jax.nn.gelu(u).reshape(B_, n_chunks, SGU_CHUNK, SGU_GROUPS, SGU_GROUP_DIM)
    v = jax.nn.gelu(v).reshape(B_, T, SGU_GROUPS, SGU_GROUP_DIM)
    v = rmsnorm(v, norm_w.reshape(SGU_GROUPS, SGU_GROUP_DIM))
    v = v.reshape(B_, n_chunks, SGU_CHUNK, SGU_GROUPS, SGU_GROUP_DIM)
    mixed = jnp.einsum('gts,bnsgc->bntgc', w_s, v) + b_s.T[:, :, None]
    return (u * mixed).reshape(B_, T, SGU_WIDTH)


def token_mixer(parts, lb_f, lb_b, hgrn_norm_w, sgu_norm_w, sgu_w, sgu_b,
                w_branch_a, w_branch_b, w_out, s0_f, s0_b, n_sgu_chunks):
    q_p, ff_p, fb_p, v_p, g_p, u_p, sv_p, ga_p, gb_p = parts
    q = jax.nn.silu(to_heads(q_p))
    v = to_heads(v_p)
    logf_f, k_f = hgrn_forget(to_heads(ff_p), lb_f)
    logf_b, k_b = hgrn_forget(to_heads(fb_p), lb_b)
    o_f, s_f = hgrn_chunk_scan(q, k_f, logf_f, v, s0_f)
    o_b, s_b = hgrn_chunk_scan(q[:, ::-1], k_b[:, ::-1], logf_b[:, ::-1], v[:, ::-1], s0_b)
    o = o_f + o_b[:, ::-1]
    o = rmsnorm(o, hgrn_norm_w.reshape(HGRN_HEADS, HGRN_DV)).astype(g_p.dtype)
    o = o.reshape(o.shape[0], o.shape[1], HGRN_WIDTH) * jax.nn.silu(g_p)
    y_a = o @ w_branch_a
    y_b = sgu(u_p, sv_p, sgu_norm_w, sgu_w, sgu_b, n_sgu_chunks) @ w_branch_b
    merged = jax.nn.sigmoid(ga_p) * y_a + jax.nn.sigmoid(gb_p) * y_b
    return merged @ w_out, s_f, s_b


def moe_expert_choice(h, router_w, w_gate, w_up, w_down):
    B_, T, _ = h.shape
    cap = CAPACITY_FACTOR * T // N_EXPERTS
    aff = jax.nn.softmax((h @ router_w).astype(jnp.float32), axis=-1)
    gate, idx = lax.top_k(jnp.swapaxes(aff, 1, 2), cap)
    bidx = jnp.arange(B_)[:, None, None]
    xs = h[bidx, idx]
    hid = jax.nn.silu(jnp.einsum('becd,edf->becf', xs, w_gate)) * jnp.einsum('becd,edf->becf', xs, w_up)
    ye = jnp.einsum('becf,efd->becd', hid, w_down) * gate[..., None].astype(h.dtype)
    return jnp.zeros_like(h).at[bidx, idx].add(ye)


def setup_inputs(seed: int = 0) -> dict:
    key = jax.random.key(seed)
    ks = jax.random.split(key, 24)
    f32 = jnp.float32
    nrm = lambda k, shape, s: jax.random.normal(k, shape, f32) * s
    return {
        'x': nrm(ks[0], (BATCH, SEQ, D_MODEL), 1.0),
        'c': nrm(ks[1], (BATCH, D_MODEL), 1.0),
        'ctx': nrm(ks[2], (BATCH, CTX_LEN, D_MODEL), 1.0),
        'c_ctx': nrm(ks[3], (D_MODEL,), 1.0),
        'ada_w': nrm(ks[4], (DEPTH, D_MODEL, N_MOD * D_MODEL), 0.02),
        'ada_b': nrm(ks[5], (DEPTH, N_MOD * D_MODEL), 0.02),
        'norm_mix_w': 1 + nrm(ks[6], (DEPTH, D_MODEL), 0.05),
        'norm_ffn_w': 1 + nrm(ks[7], (DEPTH, D_MODEL), 0.05),
        'w_in': nrm(ks[8], (DEPTH, D_MODEL, IN_COLS), D_MODEL ** -0.5),
        'hgrn_lb_logits': nrm(ks[9], (2, DEPTH + 1, HGRN_WIDTH), 0.5),
        'hgrn_norm_w': 1 + nrm(ks[10], (DEPTH, HGRN_WIDTH), 0.05),
        'sgu_norm_w': 1 + nrm(ks[11], (DEPTH, SGU_WIDTH), 0.05),
        'sgu_w': nrm(ks[12], (DEPTH, SGU_GROUPS, SGU_CHUNK, SGU_CHUNK), SGU_CHUNK ** -0.5),
        'sgu_b': 1 + nrm(ks[13], (DEPTH, SGU_GROUPS, SGU_CHUNK), 0.05),
        'w_branch_a': nrm(ks[14], (DEPTH, HGRN_WIDTH, D_MODEL), HGRN_WIDTH ** -0.5),
        'w_branch_b': nrm(ks[15], (DEPTH, SGU_WIDTH, D_MODEL), SGU_WIDTH ** -0.5),
        'w_out': nrm(ks[16], (DEPTH, D_MODEL, D_MODEL), D_MODEL ** -0.5),
        'router_w': nrm(ks[17], (DEPTH, D_MODEL, N_EXPERTS), D_MODEL ** -0.5),
        'expert_w_gate': nrm(ks[18], (DEPTH, N_EXPERTS, D_MODEL, EXPERT_FF), D_MODEL ** -0.5),
        'expert_w_up': nrm(ks[19], (DEPTH, N_EXPERTS, D_MODEL, EXPERT_FF), D_MODEL ** -0.5),
        'expert_w_down': nrm(ks[20], (DEPTH, N_EXPERTS, EXPERT_FF, D_MODEL), EXPERT_FF ** -0.5),
        'final_norm_w': 1 + nrm(ks[21], (D_MODEL,), 0.05),
    }


def reference(x, c, ctx, c_ctx, ada_w, ada_b, norm_mix_w, norm_ffn_w, w_in, hgrn_lb_logits,
              hgrn_norm_w, sgu_norm_w, sgu_w, sgu_b, w_branch_a, w_branch_b, w_out, router_w,
              expert_w_gate, expert_w_up, expert_w_down, final_norm_w):
    B_, N, _ = x.shape
    ROWS = N // GRID_W
    n_sgu_lat = ROWS // ROWS_PER_SGU_CHUNK
    n_sgu_ctx = ctx.shape[1] // SGU_CHUNK
    lb_all = jnp.cumsum(jax.nn.softmax(hgrn_lb_logits.astype(jnp.float32), axis=1), axis=1)
    for l in range(DEPTH):
        last = l == DEPTH - 1
        lb_f = lb_all[0, l].reshape(HGRN_HEADS, HGRN_DK)
        lb_b = lb_all[1, l].reshape(HGRN_HEADS, HGRN_DK)
        sh_m, sc_m, g_m, sh_f, sc_f, g_f = adaln(c, ada_w[l], ada_b[l])
        csh_m, csc_m, cg_m, csh_f, csc_f, cg_f = adaln(c_ctx, ada_w[l], ada_b[l])

        h_ctx = modulate(rmsnorm(ctx, norm_mix_w[l]), csh_m, csc_m)
        pc = split_in(h_ctx @ w_in[l])
        if last:
            v_c = to_heads(pc[3])
            logf_f, k_f = hgrn_forget(to_heads(pc[1]), lb_f)
            logf_b, k_b = hgrn_forget(to_heads(pc[2]), lb_b)
            s_f = hgrn_final_state(k_f, logf_f, v_c)
            s_b = hgrn_final_state(k_b[:, ::-1], logf_b[:, ::-1], v_c[:, ::-1])
        else:
            zeros = jnp.zeros((ctx.shape[0], HGRN_HEADS, HGRN_DK, HGRN_DV), jnp.float32)
            y_c, s_f, s_b = token_mixer(pc, lb_f, lb_b, hgrn_norm_w[l], sgu_norm_w[l], sgu_w[l], sgu_b[l],
                                        w_branch_a[l], w_branch_b[l], w_out[l], zeros, zeros, n_sgu_ctx)
            ctx = ctx + cg_m * y_c
            h2c = modulate(rmsnorm(ctx, norm_ffn_w[l]), csh_f, csc_f)
            ctx = ctx + cg_f * moe_expert_choice(h2c, router_w[l], expert_w_gate[l], expert_w_up[l], expert_w_down[l])

        h = modulate(rmsnorm(x, norm_mix_w[l]), sh_m, sc_m)
        pl = split_in(h @ w_in[l])
        y, _, _ = token_mixer(pl, lb_f, lb_b, hgrn_norm_w[l], sgu_norm_w[l], sgu_w[l], sgu_b[l],
                              w_branch_a[l], w_branch_b[l], w_out[l], s_f, s_b, n_sgu_lat)
        x = x + g_m * y
        h2 = modulate(rmsnorm(x, norm_ffn_w[l]), sh_f, sc_f)
        x = x + g_f * moe_expert_choice(h2, router_w[l], expert_w_gate[l], expert_w_up[l], expert_w_down[l])
    return rmsnorm(x, final_norm_w)
```

```cpp
#include <hip/hip_runtime.h>
#include <cstdio>
#include <cstdint>

#ifndef SCHED_GR
#define SCHED_GR 4
#endif
#ifndef MK_PER_PHASE
#define MK_PER_PHASE 0
#endif

#define GAS __attribute__((address_space(1)))
#define LAS __attribute__((address_space(3)))
typedef unsigned short bf16_t;
typedef short bf16x8 __attribute__((ext_vector_type(8)));
typedef float f32x4 __attribute__((ext_vector_type(4)));
typedef float f32x2 __attribute__((ext_vector_type(2)));
typedef unsigned u32x4 __attribute__((ext_vector_type(4)));
typedef unsigned u32x2 __attribute__((ext_vector_type(2)));
typedef GAS unsigned gu32;

constexpr int D = 1024, NB = 4, T = 8192, ML = NB * T  , CTXL = 256, MC = NB * CTXL  , MT = ML + MC  ;
constexpr int NH = 4, DK = 128, HW = 512, SW = 512, NE = 16, FF = 2048, CAP = 1024, NMOD = 6, INC = 5632;
constexpr float EPS = 1e-6f;
constexpr int NWAVES = 8, NTHR = 512;

constexpr size_t MiB = 1u << 20;
constexpr size_t WS_CTL = 0, CTL_ZERO_BYTES = 1 * MiB;
constexpr size_t WS_MOD = 1 * MiB;
constexpr size_t WS_LB = 1 * MiB + 256 * 1024;
constexpr size_t WS_WIN = 2 * MiB;
constexpr size_t WS_WA = 13 * MiB, WS_WB = 14 * MiB, WS_WO = 15 * MiB;
constexpr size_t WS_AFF = 17 * MiB;
constexpr size_t WS_ROWMAP = 19 * MiB;
constexpr size_t WS_GATE = 19 * MiB + 512 * 1024;
constexpr size_t WS_SLOT = 20 * MiB;
constexpr size_t WS_STATE = 22 * MiB;
constexpr size_t WS_DEC = 40 * MiB;
constexpr size_t WS_H = 48 * MiB;
constexpr size_t WS_Q = 114 * MiB, WS_FF = 147 * MiB, WS_FB = 180 * MiB, WS_V = 213 * MiB;
constexpr size_t WS_G = 246 * MiB, WS_U = 278 * MiB, WS_VS = 310 * MiB;
constexpr size_t WS_GA = 342 * MiB, WS_GB = 406 * MiB;
constexpr size_t WS_ODIR = 278 * MiB;
constexpr size_t WS_T = 180 * MiB;
constexpr size_t WS_MERGED = 114 * MiB;
constexpr size_t WS_WGU = 114 * MiB;
constexpr size_t WS_YE = 114 * MiB;
constexpr size_t WS_WD = 498 * MiB;
constexpr size_t WS_HID = 242 * MiB;
constexpr size_t WS_H8 = 530 * MiB;
constexpr size_t WS_W8 = WS_WIN + (size_t)3584 * 2048;
constexpr size_t WS_END = 562 * MiB;

constexpr int CW_BAR = 4096, CW_QUEUE = 8192, CW_QUEUE2 = 8192 + 64;

constexpr int RING_BYTES = 131072;
constexpr int CONV_OFF = 118784;
constexpr int LDSCTL_OFF = 155648, MISC_OFF = LDSCTL_OFF + 320, RM_OFF = LDSCTL_OFF + 2048;
constexpr int LDS_BYTES = 159744;

#define RLX_AGENT __ATOMIC_RELAXED, __HIP_MEMORY_SCOPE_AGENT
#define LDS_WAIT() asm volatile("s_waitcnt lgkmcnt(0)" ::: "memory")
#define VM_WAIT() asm volatile("s_waitcnt vmcnt(0)" ::: "memory")
__device__ __forceinline__ unsigned f2bf(float f) { unsigned u = __builtin_bit_cast(unsigned, f); return (u + 0x7fffu + ((u >> 16) & 1u)) >> 16; }
__device__ __forceinline__ unsigned pk2(float lo, float hi) { return f2bf(lo) | (f2bf(hi) << 16); }
__device__ __forceinline__ float bf2f(unsigned short h) { return __builtin_bit_cast(float, (unsigned)h << 16); }
__device__ __forceinline__ float bflo(unsigned w) { return __builtin_bit_cast(float, w << 16); }
__device__ __forceinline__ float bfhi(unsigned w) { return __builtin_bit_cast(float, w & 0xffff0000u); }
typedef __bf16 bf16x2_t __attribute__((ext_vector_type(2)));
__device__ __forceinline__ unsigned cvt_pk_bf16(float lo, float hi) { f32x2 v = {lo, hi}; bf16x2_t b = __builtin_convertvector(v, bf16x2_t); return __builtin_bit_cast(unsigned, b); }
__device__ __forceinline__ float clamp448(float v) { return copysignf(fminf(fabsf(v), 448.f), v); }
__device__ __forceinline__ unsigned pk4_f8(float a, float b, float c, float d) {
    const float a1 = clamp448(a);
    const int w = __builtin_amdgcn_cvt_pk_fp8_f32(a1, clamp448(b), __builtin_bit_cast(int, a1), false);
    return (unsigned)__builtin_amdgcn_cvt_pk_fp8_f32(clamp448(c), clamp448(d), w, true);
}
constexpr float SC_W8 = 1024.f, SC_H8 = 16.f, SC_HID8 = 8.f, SC_YE8 = 64.f;
__device__ __forceinline__ f32x4 f8x4_f32(unsigned w) { const f32x2 lo = __builtin_amdgcn_cvt_pk_f32_fp8((int)w, false), hi = __builtin_amdgcn_cvt_pk_f32_fp8((int)w, true); return (f32x4){lo[0], lo[1], hi[0], hi[1]}; }
__device__ __forceinline__ float sigm(float x) { return __builtin_amdgcn_rcpf(1.f + __expf(-x)); }
__device__ __forceinline__ float siluf(float x) { return x * sigm(x); }
__device__ __forceinline__ float geluf(float x) { return x * sigm(1.5957691216057308f * (x + 0.044715f * x * x * x)); }
__device__ __forceinline__ float wave_sum(float v) {
#pragma unroll
    for (int o = 1; o < 64; o <<= 1) v += __shfl_xor(v, o);
    return v;
}

#define XB_TMO      128
#define XB_XCNT(j)  (256  + 64 * (j))
#define XB_XSUB(j)  (1280 + 64 * (j))
#define XB_XGEN(j)  (2304 + 64 * (j))
#define XB_TOP      3328
#define XB_TOPGEN   3392
#define XCD_BAR_WORDS 3456
#define XB_SPIN_CAP (1u << 20)
__device__ __forceinline__ unsigned xb_ld(unsigned* p)              { return __hip_atomic_load(p, __ATOMIC_RELAXED, __HIP_MEMORY_SCOPE_AGENT); }
__device__ __forceinline__ unsigned xb_add(unsigned* p, unsigned v) { return __hip_atomic_fetch_add(p, v, __ATOMIC_RELAXED, __HIP_MEMORY_SCOPE_AGENT); }
__device__ __forceinline__ unsigned xb_xcc_id() { return (unsigned)__builtin_amdgcn_s_getreg((3 << 11) | 20) & 0xFu; }
#define XB_SPIN(cond, bar) do { unsigned _sp = 0; while (cond) { __builtin_amdgcn_s_sleep(1); \
    if ((++_sp & 255u) == 0u) { if (xb_ld(&(bar)[XB_TMO])) break; if (_sp > XB_SPIN_CAP) { atomicAdd(&(bar)[XB_TMO], 1u); break; } } } } while (0)
struct XcdBarrier { unsigned* bar; unsigned x; volatile LAS unsigned* st; };
__device__ __forceinline__ XcdBarrier xcd_barrier_post(unsigned* bar, volatile LAS unsigned* st) {
    XcdBarrier b; b.bar = bar; b.x = xb_xcc_id(); b.st = st;
    if (threadIdx.x == 0) (void)xb_add(&bar[XB_XCNT(b.x)], 1u);
    return b;
}
__device__ __forceinline__ void xcd_barrier_complete(unsigned* bar, unsigned x, unsigned& nloc, unsigned& nx) {
    const unsigned G = gridDim.x * gridDim.y * gridDim.z;
    unsigned sum, cnt, mine, sp = 0u;
    for (;;) {
        sum = 0u; cnt = 0u; mine = 0u;
#pragma unroll
        for (unsigned j = 0; j < 16; ++j) { const unsigned c = xb_ld(&bar[XB_XCNT(j)]); sum += c; cnt += (c > 0u) ? 1u : 0u; mine = (j == x) ? c : mine; }
        if (sum == G) break;
        __builtin_amdgcn_s_sleep(1);
        if ((++sp & 255u) == 0u) { if (xb_ld(&bar[XB_TMO])) break; if (sp > XB_SPIN_CAP) { atomicAdd(&bar[XB_TMO], 1u); break; } }
    }
    nloc = mine > 0u ? mine : 1u; nx = cnt > 0u ? cnt : 1u;
}
__device__ __forceinline__ void xcd_barrier(const XcdBarrier& b) {
    asm volatile("s_waitcnt vmcnt(0)" ::: "memory");
    __syncthreads();
    if (threadIdx.x == 0) {
        unsigned* bar = b.bar;
        __builtin_amdgcn_s_waitcnt(0);
        unsigned nloc = b.st[0], nx = b.st[1];
        if (nloc == 0u) { xcd_barrier_complete(bar, b.x, nloc, nx); b.st[0] = nloc; b.st[1] = nx; }
        const unsigned old = xb_add(&bar[XB_XSUB(b.x)], 1u);
        const unsigned gen = old / nloc;
        if (old + 1u == (gen + 1u) * nloc) {
            __builtin_amdgcn_fence(__ATOMIC_RELEASE, "agent");
            asm volatile("s_waitcnt vmcnt(0)" ::: "memory");
            const unsigned og = xb_add(&bar[XB_TOP], 1u);
            const unsigned tg = og / nx;
            if (og + 1u == (tg + 1u) * nx) xb_add(&bar[XB_TOPGEN], 1u);
            else XB_SPIN(xb_ld(&bar[XB_TOPGEN]) == tg, bar);
            __builtin_amdgcn_fence(__ATOMIC_ACQUIRE, "agent");
            xb_add(&bar[XB_XGEN(b.x)], 1u);
            asm volatile("s_waitcnt vmcnt(0)" ::: "memory");
        } else {
            XB_SPIN(xb_ld(&bar[XB_XGEN(b.x)]) == gen, bar);
            __builtin_amdgcn_fence(__ATOMIC_ACQUIRE, "agent");
            asm volatile("s_waitcnt vmcnt(0)" ::: "memory");
        }
    }
    __syncthreads();
}

namespace pg8 {
constexpr int BM = 256, BK = 64, HALF = 128, HTB = HALF * BK * 2, STAGE_BYTES = 8 * HTB;
__host__ __device__ __forceinline__ int lds_byte(int r, int c) { const int st = (r >> 4) * 2 + (c >> 5), rr = r & 15, cc = c & 31, ob = rr * 64 + cc * 2; return st * 1024 + (ob ^ (((ob >> 9) & 1) << 5)); }
__host__ __device__ __forceinline__ void stage_rc(int b, int& R, int& C) { const int st = b / 1024, sb = b % 1024, swz = sb ^ (((sb >> 9) & 1) << 5); R = (st >> 1) * 16 + swz / 64; C = (st & 1) * 32 + (swz % 64) / 2; }
__host__ __device__ __forceinline__ int perm32(int rho) { const int n = rho >> 4, i = rho & 15; return 8 * (i >> 2) + 4 * n + (i & 3); }
struct Unit { int pm, pn, b0, b1; };
__device__ __forceinline__ void std_halves(Unit& u) { u.b0 = u.pn * 256; u.b1 = u.pn * 256 + 128; }

__device__ __forceinline__ const char* sptr(const char* p) { const unsigned long long v = (unsigned long long)p;
    const unsigned lo = (unsigned)__builtin_amdgcn_readfirstlane((int)(unsigned)v), hi = (unsigned)__builtin_amdgcn_readfirstlane((int)(unsigned)(v >> 32));
    return (const char*)(((unsigned long long)hi << 32) | lo); }
struct NoHook { static constexpr bool ON = false; __device__ __forceinline__ void operator()(f32x4 (&)[2][2][4][2], const Unit&, int, int, int, int) const {} };
typedef int i32x8 __attribute__((ext_vector_type(8)));
typedef int i32x4 __attribute__((ext_vector_type(4)));
__device__ __forceinline__ void mma8(f32x4& c, const bf16x8& a0, const bf16x8& a1, const bf16x8& b0, const bf16x8& b1) {
    const i32x4 x0 = __builtin_bit_cast(i32x4, a0), x1 = __builtin_bit_cast(i32x4, a1), y0 = __builtin_bit_cast(i32x4, b0), y1 = __builtin_bit_cast(i32x4, b1);
    const i32x8 X = {x0[0], x0[1], x0[2], x0[3], x1[0], x1[1], x1[2], x1[3]}, Y = {y0[0], y0[1], y0[2], y0[3], y1[0], y1[1], y1[2], y1[3]};
    asm volatile("v_mfma_f32_16x16x128_f8f6f4 %0, %1, %2, %0" : "+v"(c) : "v"(X), "v"(Y));
}
template <class Epi, class Sched, bool GATHER, class Hook = NoHook, bool F8 = false>
__device__ __forceinline__ void gemm_phase(LAS unsigned char* lds, const bf16_t* A, const int lda, const bf16_t* Bt, const int K, const int* rowmap, const Sched& S, const Epi& E, const Hook& HK = Hook()) {
    int tid_ = threadIdx.x; asm volatile("" : "+v"(tid_));
    const int tid = tid_, wid = __builtin_amdgcn_readfirstlane(tid >> 6), lane = tid & 63, wr = wid >> 2, wc = wid & 3, fr = lane & 15, fq = lane >> 4;
    const int nt = K / BK;
    const unsigned rowB = (unsigned)lda * 2u;
    unsigned CA2, voffB, voffA; int vRM;
    { int R, C; stage_rc(tid * 16, R, C); const int Rb = Epi::PERM ? ((R & ~31) + perm32(R & 31)) : R;
        CA2 = (unsigned)C * 2u; voffB = (unsigned)(Rb * K + C) * 2u; voffA = (unsigned)R * rowB + (unsigned)C * 2u; vRM = RM_OFF + R * 4; }
    const size_t kstep = (size_t)(BK * 2);
    const size_t rowK = (size_t)K * 2;
    const size_t halfA = (size_t)HALF * rowB, d64A = (size_t)64 * rowB, d64B = (size_t)64 * rowK;
    const unsigned ldsw = (unsigned)wid * 1024u;
    const int aoff = lds_byte(wr * 64 + fr, fq * 8), boff = lds_byte(wc * 32 + fr, fq * 8);
#define PG8_SA(b, h) (((b) * 2 + (h)) * HTB)
#define PG8_SB(b, h) ((4 + (b) * 2 + (h)) * HTB)
#define PG8_DMA(bufoff, i, ptr) __builtin_amdgcn_global_load_lds((const unsigned*)(ptr), (LAS unsigned*)(lds + (bufoff) + ldsw + (i) * 8192), 16, 0, 0)
#define PG8_STAGE(bufoff, gbase, voff, delta) do { const char* _g0 = sptr((const char*)(gbase)); const char* _g1 = sptr((const char*)(gbase) + (delta)); \
        unsigned _o = (voff); asm volatile("" : "+v"(_o)); PG8_DMA(bufoff, 0, _g0 + _o); PG8_DMA(bufoff, 1, _g1 + _o); } while (0)
#define PG8_STAGE_G(bufoff, gbase, offs) do { const char* _g = sptr((const char*)(gbase)); _Pragma("unroll") for (int _i = 0; _i < 2; ++_i) { \
        unsigned _o = (offs)[_i]; asm volatile("" : "+v"(_o)); PG8_DMA(bufoff, _i, _g + _o); } } while (0)
#define PG8_STAGE_B(bufoff, gbase) PG8_STAGE(bufoff, gbase, voffB, d64B)
#define PG8_RMGET(dst, h, nu) do { if constexpr (GATHER) { const int _ro = ((nu) ? (rmbuf ^ 1) : rmbuf) * 1024 + (h) * 512; \
        _Pragma("unroll") for (int _i = 0; _i < 2; ++_i) dst[_i] = *(const LAS unsigned*)(lds + vRM + _ro + _i * 256) * rowB + CA2; } } while (0)
#define PG8_STAGE_A(bufoff, kb, h, nu, offs) do { if constexpr (GATHER) PG8_STAGE_G(bufoff, (const char*)A + (kb), offs); \
        else PG8_STAGE(bufoff, ((nu) ? nAu : cAu) + (size_t)(h) * halfA + (kb), voffA, d64A); } while (0)
#define PG8_LDA(dst, b, h) do { _Pragma("unroll") for (int m = 0; m < 4; ++m) _Pragma("unroll") for (int k = 0; k < 2; ++k) dst[m][k] = *(const LAS bf16x8*)(lds + PG8_SA(b, h) + aoff + m * 2048 + k * 1024); } while (0)
#define PG8_LDB(dst, b, h) do { _Pragma("unroll") for (int n = 0; n < 2; ++n) _Pragma("unroll") for (int k = 0; k < 2; ++k) dst[n][k] = *(const LAS bf16x8*)(lds + PG8_SB(b, h) + boff + n * 2048 + k * 1024); } while (0)
#define PG8_MMA(ai, bj, At, Bt_) do { __builtin_amdgcn_s_setprio(1); _Pragma("unroll") for (int m = 0; m < 4; ++m) _Pragma("unroll") for (int n = 0; n < 2; ++n) { \
        if constexpr (F8) mma8(acc[ai][bj][m][n], Bt_[n][0], Bt_[n][1], At[m][0], At[m][1]); \
        else { _Pragma("unroll") for (int k = 0; k < 2; ++k) acc[ai][bj][m][n] = __builtin_amdgcn_mfma_f32_16x16x32_bf16(Bt_[n][k], At[m][k], acc[ai][bj][m][n], 0, 0, 0); } } \
        __builtin_amdgcn_s_setprio(0); } while (0)
#define PG8_WAIT_V(n) asm volatile("s_waitcnt vmcnt(" #n ")" ::: "memory")
#define PG8_WAIT_L(n) asm volatile("s_waitcnt lgkmcnt(" #n ")" ::: "memory")
#define PG8_BAR __builtin_amdgcn_s_barrier()
#define PG8_SCHED __builtin_amdgcn_sched_barrier(0)
    Unit cur, nxt; int ui = 0;
    if (!S.next(0, cur)) return;
    int rmbuf = 0;
    if constexpr (GATHER) {
        if (wid < 4) { unsigned _o = (unsigned)tid * 4u; asm volatile("" : "+v"(_o)); __builtin_amdgcn_global_load_lds((const unsigned*)(sptr((const char*)(rowmap + cur.pm * BM)) + _o), (LAS unsigned*)(lds + RM_OFF + wid * 256), 4, 0, 0); }
        PG8_WAIT_V(0); __syncthreads();
    }
    f32x4 acc[2][2][4][2];
#pragma unroll
    for (int a = 0; a < 2; ++a)
#pragma unroll
        for (int b = 0; b < 2; ++b)
#pragma unroll
            for (int m = 0; m < 4; ++m)
#pragma unroll
                for (int n = 0; n < 2; ++n) acc[a][b][m][n] = (f32x4){0.f, 0.f, 0.f, 0.f};
    bf16x8 At[4][2], B0[2][2], B1[2][2];
    const char* cAu = (const char*)A + (GATHER ? (size_t)0 : (size_t)(cur.pm * BM) * rowB); const char* nAu = cAu;
    const char* cB0 = (const char*)Bt + (size_t)cur.b0 * rowK; const char* cB1 = (const char*)Bt + (size_t)cur.b1 * rowK;
    unsigned ro[2] = {0u, 0u}, ro1[2] = {0u, 0u};
    PG8_RMGET(ro, 0, false); PG8_RMGET(ro1, 1, false);
    PG8_STAGE_B(PG8_SB(0, 0), cB0); PG8_STAGE_B(PG8_SB(0, 1), cB1); PG8_STAGE_A(PG8_SA(0, 0), (size_t)0, 0, false, ro); PG8_STAGE_A(PG8_SA(0, 1), (size_t)0, 1, false, ro1);
    if (wr == 1) PG8_BAR;
    PG8_WAIT_V(2); PG8_BAR;
    PG8_STAGE_B(PG8_SB(1, 0), cB0 + kstep); PG8_STAGE_A(PG8_SA(1, 0), kstep, 0, false, ro); PG8_STAGE_B(PG8_SB(1, 1), cB1 + kstep);
    PG8_WAIT_V(6); PG8_BAR;
    for (;;) {
        const bool has_next = S.next(ui + 1, nxt);
        const char* nB0 = has_next ? (const char*)Bt + (size_t)nxt.b0 * rowK : cB0; const char* nB1 = has_next ? (const char*)Bt + (size_t)nxt.b1 * rowK : cB1;
        if constexpr (GATHER) {
            if (has_next && wid < 4) { unsigned _o = (unsigned)tid * 4u; asm volatile("" : "+v"(_o)); __builtin_amdgcn_global_load_lds((const unsigned*)(sptr((const char*)(rowmap + nxt.pm * BM)) + _o), (LAS unsigned*)(lds + RM_OFF + (rmbuf ^ 1) * 1024 + wid * 256), 4, 0, 0); }
        } else nAu = has_next ? (const char*)A + (size_t)(nxt.pm * BM) * rowB : cAu;
#pragma unroll 1
        for (int t = 0; t < nt; t += 2) {
            const bool last = (t == nt - 2), nu = last && has_next;
            if constexpr (Hook::ON) { if (t == nt / 2) HK(acc, cur, wr, wc, fr, fq); }
            const size_t k1 = (size_t)(t + 1) * kstep, k2 = last ? (size_t)0 : (size_t)(t + 2) * kstep, k3 = k2 + kstep;
            const char* b20 = last ? nB0 : cB0 + k2; const char* b21 = last ? nB1 : cB1 + k2;
            const char* b30 = b20 + kstep; const char* b31 = b21 + kstep;
            PG8_RMGET(ro, 1, false); PG8_LDB(B0, 0, 0); PG8_LDB(B1, 0, 1); PG8_SCHED; PG8_LDA(At, 0, 0); PG8_STAGE_A(PG8_SA(1, 1), k1, 1, false, ro);
            PG8_WAIT_V(8); PG8_WAIT_L(0); PG8_BAR; PG8_MMA(0, 0, At, B0); PG8_MMA(0, 1, At, B1); PG8_BAR; PG8_SCHED;
            PG8_RMGET(ro, 0, nu); PG8_LDA(At, 0, 1); PG8_STAGE_B(PG8_SB(0, 0), b20); PG8_STAGE_B(PG8_SB(0, 1), b21); PG8_STAGE_A(PG8_SA(0, 0), k2, 0, last, ro);
            PG8_WAIT_V(8); PG8_WAIT_L(0); PG8_BAR; PG8_MMA(1, 0, At, B0); PG8_MMA(1, 1, At, B1); PG8_BAR; PG8_SCHED;
            PG8_RMGET(ro, 1, nu); PG8_LDB(B0, 1, 0); PG8_LDB(B1, 1, 1); PG8_SCHED; PG8_LDA(At, 1, 0); PG8_STAGE_A(PG8_SA(0, 1), k2, 1, last, ro);
            PG8_WAIT_V(8); PG8_WAIT_L(0); PG8_BAR; PG8_MMA(0, 0, At, B0); PG8_MMA(0, 1, At, B1); PG8_BAR; PG8_SCHED;
            PG8_RMGET(ro, 0, nu); PG8_LDA(At, 1, 1); PG8_STAGE_B(PG8_SB(1, 0), b30); PG8_STAGE_B(PG8_SB(1, 1), b31); PG8_STAGE_A(PG8_SA(1, 0), k3, 0, last, ro);
            PG8_WAIT_V(8); PG8_WAIT_L(0); PG8_BAR; PG8_MMA(1, 0, At, B0); PG8_MMA(1, 1, At, B1); PG8_BAR; PG8_SCHED;
        }
        if (wr == 0) PG8_BAR;
        if constexpr (F8) asm volatile("s_nop 7\n\ts_nop 7\n\ts_nop 7" ::: "memory");
        E(acc, cur, wr, wc, fr, fq);
        if (!has_next) break;
#pragma unroll
        for (int a = 0; a < 2; ++a)
#pragma unroll
            for (int b = 0; b < 2; ++b)
#pragma unroll
                for (int m = 0; m < 4; ++m)
#pragma unroll
                    for (int n = 0; n < 2; ++n) acc[a][b][m][n] = (f32x4){0.f, 0.f, 0.f, 0.f};
        cur = nxt; cB0 = nB0; cB1 = nB1; cAu = nAu; ++ui; rmbuf ^= 1;
        if (wr == 1) PG8_BAR;
    }
    PG8_WAIT_V(0);
    PG8_BAR;
#undef PG8_SA
#undef PG8_SB
#undef PG8_STAGE
#undef PG8_DMA
#undef PG8_STAGE_G
#undef PG8_STAGE_B
#undef PG8_RMGET
#undef PG8_STAGE_A
#undef PG8_LDA
#undef PG8_LDB
#undef PG8_MMA
#undef PG8_WAIT_V
#undef PG8_WAIT_L
#undef PG8_BAR
#undef PG8_SCHED
}
}

enum { I_X = 0, I_C, I_CTX, I_CCTX, I_ADAW, I_ADAB, I_NMIX, I_NFFN, I_WIN, I_LBL, I_HNW, I_SNW, I_SGUW, I_SGUB, I_WBA, I_WBB, I_WOUT, I_RW, I_EWG, I_EWU, I_EWD, I_FNW, N_IN };
struct Args { const float* in[N_IN]; float* out; unsigned char* ws; int ph_lo, ph_hi; };
struct InTab { __device__ __forceinline__ const float* operator[](int i) const {
    typedef const float* __attribute__((address_space(4))) const* kptr_t;
    return ((kptr_t)__builtin_amdgcn_kernarg_segment_ptr())[i]; } };
struct Frame {
    LAS unsigned char* lds;
    int tid, lane, wave, G, bid, vcu;
    InTab in;
    float* out; unsigned char* ws;
};
using pg8::Unit;

struct StaticOrder {
    int nM, nN, nwg, G, c;
    __device__ __forceinline__ void init(int nM_, int nN_, int G_, int c_) { nM = nM_; nN = nN_; nwg = nM * nN; G = G_; c = c_; }
    __device__ __forceinline__ bool decode(int L, Unit& u) const {
        int wgid = L; { const int q = nwg / 8, r = nwg % 8, xcd = wgid % 8, off = wgid / 8; wgid = (xcd < r ? xcd * (q + 1) : r * (q + 1) + (xcd - r) * q) + off; }
        const int nig = 8 * nN, gid = wgid / nig, fm = gid * 8, gsz = (nM - fm) < 8 ? (nM - fm) : 8;
        u.pm = fm + ((wgid % nig) % gsz); u.pn = (wgid % nig) / gsz; pg8::std_halves(u); return true;
    }
    __device__ __forceinline__ bool next(int i, Unit& u) const { const long L = (long)i * G + c; if (L >= nwg) return false; return decode((int)L, u); }
};
struct SchedIn {
    int G, c, nct;
    __device__ __forceinline__ void init(int G_, int c_, int nct_) { G = G_; c = c_; nct = nct_; }
    __device__ __forceinline__ bool next(int i, Unit& u) const {
        const int L = i * G + c; if (L >= 128 * nct) return false;
        constexpr int GR = SCHED_GR;
        const int xcd = L & 7, off = L >> 3;
        const int grp = off / (GR * nct), rem = off % (GR * nct);
        u.pm = xcd * 16 + grp * GR + rem % GR; u.pn = (rem / GR + 3 * xcd) % nct; pg8::std_halves(u); return true;
    }
};
struct SchedCtx {
    int b, h, dir;
    __device__ __forceinline__ bool next(int i, Unit& u) const { if (i > 0) return false; u.pm = 128 + b; u.pn = dir * 4 + h; u.b0 = 512 + dir * 512 + h * 128; u.b1 = 1536 + h * 128; return true; }
};
struct SchedMoe1 {
    int G, c;
    __device__ __forceinline__ bool next(int i, Unit& u) const {
        const int L = i * G + c; if (L >= 4096) return false;
        const int e = L >> 8, r = L & 255, xcd = r >> 5, j = r & 31;
        const int rt16 = (xcd >> 1) * 4 + (j >> 3), ct = (xcd & 1) * 8 + (j & 7), b = rt16 >> 2, rt = rt16 & 3;
        u.pm = (b * NE + e) * 4 + rt; u.pn = e * 16 + ct; pg8::std_halves(u); return true;
    }
};
struct SchedMoe2 {
    int G, c;
    __device__ __forceinline__ bool next(int i, Unit& u) const {
        const int L = i * G + c; if (L >= 1024) return false;
        const int e = L >> 6, r = L & 63, rt16 = r >> 2, ct = r & 3, b = rt16 >> 2, rt = rt16 & 3;
        u.pm = (b * NE + e) * 4 + rt; u.pn = e * 4 + ct; pg8::std_halves(u); return true;
    }
};

enum { ACT_NONE = 0, ACT_SILU, ACT_LOGF, ACT_GELU, ACT_SIGM };
template <int MODE> __device__ __forceinline__ float act1(float v, float lb) {
    if (MODE == ACT_SILU) return siluf(v);
    if (MODE == ACT_GELU) return geluf(v);
    if (MODE == ACT_SIGM) return sigm(v);
    if (MODE == ACT_LOGF) return __logf(lb + (1.f - lb) * sigm(v));
    return v;
}
template <int MODE> __device__ __forceinline__ void epi_store_act(const f32x4 (&acc)[2][2][4][2], bf16_t* base, int ld, int row0, int col0, const float* lbp) {
    float lbv[2][8];
#pragma unroll
    for (int bj = 0; bj < 2; ++bj)
#pragma unroll
        for (int j = 0; j < 8; ++j) lbv[bj][j] = (MODE == ACT_LOGF) ? lbp[col0 + bj * 128 + j] : 0.f;
#pragma unroll
    for (int ai = 0; ai < 2; ++ai)
#pragma unroll
        for (int m = 0; m < 4; ++m) { unsigned ro = (unsigned)((row0 + ai * 128 + m * 16) * ld + col0) * 2u; asm volatile("" : "+v"(ro));
            bf16_t* rowp = (bf16_t*)((unsigned char*)base + ro);
#pragma unroll
            for (int bj = 0; bj < 2; ++bj) { const f32x4 v0 = acc[ai][bj][m][0], v1 = acc[ai][bj][m][1];
                u32x4 w;
                w.x = cvt_pk_bf16(act1<MODE>(v0[0], lbv[bj][0]), act1<MODE>(v0[1], lbv[bj][1])); w.y = cvt_pk_bf16(act1<MODE>(v0[2], lbv[bj][2]), act1<MODE>(v0[3], lbv[bj][3]));
                w.z = cvt_pk_bf16(act1<MODE>(v1[0], lbv[bj][4]), act1<MODE>(v1[1], lbv[bj][5])); w.w = cvt_pk_bf16(act1<MODE>(v1[2], lbv[bj][6]), act1<MODE>(v1[3], lbv[bj][7]));
                *(u32x4*)(rowp + bj * 128) = w; } }
}
struct EpiIn {
    static constexpr bool PERM = true;
    unsigned char* ws;
    __device__ __forceinline__ void operator()(const f32x4 (&acc)[2][2][4][2], const Unit& u, int wr, int wc, int fr, int fq) const {
        const int pn = u.pn; const int row0 = u.pm * 256 + wr * 64 + fr; const int cw = wc * 32 + 8 * fq;
        const float* lb = (const float*)(ws + WS_LB);
        if (pn < 2)       epi_store_act<ACT_SILU>(acc, (bf16_t*)(ws + WS_Q), 512, row0, pn * 256 + cw, nullptr);
        else if (pn < 4)  epi_store_act<ACT_LOGF>(acc, (bf16_t*)(ws + WS_FF), 512, row0, (pn - 2) * 256 + cw, lb);
        else if (pn < 6)  epi_store_act<ACT_LOGF>(acc, (bf16_t*)(ws + WS_FB), 512, row0, (pn - 4) * 256 + cw, lb + 512);
        else if (pn < 8)  epi_store_act<ACT_NONE>(acc, (bf16_t*)(ws + WS_V), 512, row0, (pn - 6) * 256 + cw, nullptr);
        else if (pn < 10) epi_store_act<ACT_SILU>(acc, (bf16_t*)(ws + WS_G), 512, row0, (pn - 8) * 256 + cw, nullptr);
        else if (pn < 12) epi_store_act<ACT_GELU>(acc, (bf16_t*)(ws + WS_U), 512, row0, (pn - 10) * 256 + cw, nullptr);
        else              epi_store_act<ACT_GELU>(acc, (bf16_t*)(ws + WS_VS), 512, row0, (pn - 12) * 256 + cw, nullptr);
    }
};
struct EpiGab {
    static constexpr bool PERM = true;
    unsigned char* ws;
    __device__ __forceinline__ void operator()(const f32x4 (&acc)[2][2][4][2], const Unit& u, int wr, int wc, int fr, int fq) const {
        const int row0 = u.pm * 256 + wr * 64 + fr, col0 = u.pn * 128 + wc * 32 + 8 * fq;
        constexpr float SI = -1.f / (SC_H8 * SC_W8);
#pragma unroll
        for (int ai = 0; ai < 2; ++ai)
#pragma unroll
            for (int m = 0; m < 4; ++m) { unsigned ro = (unsigned)((row0 + ai * 128 + m * 16) * 1024 + col0) * 2u; asm volatile("" : "+v"(ro));
                float rr[8], sb[8];
#pragma unroll
                for (int e = 0; e < 8; ++e) { const float ea = __expf(acc[ai][0][m][e >> 2][e & 3] * SI), eb = __expf(acc[ai][1][m][e >> 2][e & 3] * SI);
                    sb[e] = __builtin_amdgcn_rcpf(1.f + eb); rr[e] = (1.f + eb) * __builtin_amdgcn_rcpf(1.f + ea); }
                u32x4 w; w.x = cvt_pk_bf16(rr[0], rr[1]); w.y = cvt_pk_bf16(rr[2], rr[3]); w.z = cvt_pk_bf16(rr[4], rr[5]); w.w = cvt_pk_bf16(rr[6], rr[7]);
                *(u32x4*)(ws + WS_GA + ro) = w;
                w.x = cvt_pk_bf16(sb[0], sb[1]); w.y = cvt_pk_bf16(sb[2], sb[3]); w.z = cvt_pk_bf16(sb[4], sb[5]); w.w = cvt_pk_bf16(sb[6], sb[7]);
                *(u32x4*)(ws + WS_GB + ro) = w; }
    }
};
struct SchedGab {
    SchedIn s;
    __device__ __forceinline__ bool next(int i, Unit& u) const { if (!s.next(i, u)) return false; u.b0 = u.pn * 128; u.b1 = 1024 + u.pn * 128; return true; }
};
struct EpiCtx {
    static constexpr bool PERM = true;
    unsigned char* ws;
    __device__ __forceinline__ void operator()(const f32x4 (&acc)[2][2][4][2], const Unit& u, int wr, int wc, int fr, int fq) const {
        const int dir = u.pn >> 2, h = u.pn & 3; const int row0 = u.pm * 256 + wr * 64 + fr, col0 = h * 128 + wc * 32 + 8 * fq;
        const float* lb = (const float*)(ws + WS_LB) + dir * 512;
        bf16_t* FO = (bf16_t*)(ws + (dir ? WS_FB : WS_FF)); bf16_t* VO = (bf16_t*)(ws + WS_V);
        float lbv[8];
#pragma unroll
        for (int j = 0; j < 8; ++j) lbv[j] = lb[col0 + j];
#pragma unroll
        for (int ai = 0; ai < 2; ++ai)
#pragma unroll
            for (int m = 0; m < 4; ++m) { const size_t ro = (size_t)(row0 + ai * 128 + m * 16) * 512 + col0;
                { const f32x4 v0 = acc[ai][0][m][0], v1 = acc[ai][0][m][1]; u32x4 w;
                  w.x = cvt_pk_bf16(act1<ACT_LOGF>(v0[0], lbv[0]), act1<ACT_LOGF>(v0[1], lbv[1])); w.y = cvt_pk_bf16(act1<ACT_LOGF>(v0[2], lbv[2]), act1<ACT_LOGF>(v0[3], lbv[3]));
                  w.z = cvt_pk_bf16(act1<ACT_LOGF>(v1[0], lbv[4]), act1<ACT_LOGF>(v1[1], lbv[5])); w.w = cvt_pk_bf16(act1<ACT_LOGF>(v1[2], lbv[6]), act1<ACT_LOGF>(v1[3], lbv[7]));
                  *(u32x4*)(FO + ro) = w; }
                { const f32x4 v0 = acc[ai][1][m][0] + 0.f, v1 = acc[ai][1][m][1] + 0.f; u32x4 w;
                  w.x = cvt_pk_bf16(v0[0], v0[1]); w.y = cvt_pk_bf16(v0[2], v0[3]); w.z = cvt_pk_bf16(v1[0], v1[1]); w.w = cvt_pk_bf16(v1[2], v1[3]);
                  *(u32x4*)(VO + ro) = w; } }
    }
};
template <bool ADD> struct EpiGate {
    static constexpr bool PERM = true;
    const bf16_t* gate; const bf16_t* prev; bf16_t* out;
    __device__ __forceinline__ void operator()(const f32x4 (&acc)[2][2][4][2], const Unit& u, int wr, int wc, int fr, int fq) const {
        const int row0 = u.pm * 256 + wr * 64 + fr, col0 = u.pn * 256 + wc * 32 + 8 * fq;
#pragma unroll
        for (int ai = 0; ai < 2; ++ai)
#pragma unroll
            for (int m = 0; m < 4; ++m) { const size_t ro = (size_t)(row0 + ai * 128 + m * 16) * 1024 + col0;
#pragma unroll
                for (int bj = 0; bj < 2; ++bj) { const f32x4 v0 = acc[ai][bj][m][0], v1 = acc[ai][bj][m][1];
                    const u32x4 g = *(const u32x4*)(gate + ro + bj * 128);
                    float r[8] = {v0[0] * bflo(g.x), v0[1] * bfhi(g.x), v0[2] * bflo(g.y), v0[3] * bfhi(g.y), v1[0] * bflo(g.z), v1[1] * bfhi(g.z), v1[2] * bflo(g.w), v1[3] * bfhi(g.w)};
                    if (ADD) { const u32x4 p = *(const u32x4*)(prev + ro + bj * 128);
                        r[0] += bflo(p.x); r[1] += bfhi(p.x); r[2] += bflo(p.y); r[3] += bfhi(p.y); r[4] += bflo(p.z); r[5] += bfhi(p.z); r[6] += bflo(p.w); r[7] += bfhi(p.w); }
                    u32x4 w; w.x = cvt_pk_bf16(r[0], r[1]); w.y = cvt_pk_bf16(r[2], r[3]); w.z = cvt_pk_bf16(r[4], r[5]); w.w = cvt_pk_bf16(r[6], r[7]);
                    *(u32x4*)(out + ro + bj * 128) = w; } }
    }
};
struct HookRatio {
    static constexpr bool ON = true;
    const bf16_t* ratio;
    __device__ __forceinline__ void operator()(f32x4 (&acc)[2][2][4][2], const Unit& u, int wr, int wc, int fr, int fq) const {
        int row0 = u.pm * 256 + wr * 64 + fr, col0 = u.pn * 256 + wc * 32 + 8 * fq;
        asm volatile("" : "+v"(row0), "+v"(col0));
#pragma unroll
        for (int ai = 0; ai < 2; ++ai)
#pragma unroll
            for (int m = 0; m < 4; ++m) { const size_t ro = (size_t)(row0 + ai * 128 + m * 16) * 1024 + col0;
#pragma unroll
                for (int bj = 0; bj < 2; ++bj) { const u32x4 a = __builtin_nontemporal_load((const u32x4*)(ratio + ro + bj * 128));
                    const unsigned aw[4] = {a.x, a.y, a.z, a.w};
#pragma unroll
                    for (int e = 0; e < 4; ++e) { acc[ai][bj][m][e >> 1][2 * (e & 1)] *= bflo(aw[e]); acc[ai][bj][m][e >> 1][2 * (e & 1) + 1] *= bfhi(aw[e]); } }
                asm volatile("" ::: "memory"); }
    }
};
struct EpiX1 {
    static constexpr bool PERM = true;
    const float* x; const float* mod; bf16_t* out;
    __device__ __forceinline__ void operator()(const f32x4 (&acc)[2][2][4][2], const Unit& u, int wr, int wc, int fr, int fq) const {
        const int row0 = u.pm * 256 + wr * 64 + fr, col0 = u.pn * 256 + wc * 32 + 8 * fq;
        const float* gm = mod + (size_t)(u.pm >> 5) * (NMOD * D) + 2 * D;
        f32x4 gv[2][2];
#pragma unroll
        for (int bj = 0; bj < 2; ++bj)
#pragma unroll
            for (int n = 0; n < 2; ++n) gv[bj][n] = *(const f32x4*)(gm + col0 + bj * 128 + 4 * n);
#pragma unroll
        for (int ai = 0; ai < 2; ++ai)
#pragma unroll
            for (int m = 0; m < 4; ++m) { const size_t row = (size_t)(row0 + ai * 128 + m * 16);
#pragma unroll
                for (int bj = 0; bj < 2; ++bj) { const float* xp = x + row * D + col0 + bj * 128;
                    const f32x4 x0 = __builtin_nontemporal_load((const f32x4*)xp), x1v = __builtin_nontemporal_load((const f32x4*)(xp + 4));
                    const f32x4 v0 = x0 + gv[bj][0] * acc[ai][bj][m][0], v1 = x1v + gv[bj][1] * acc[ai][bj][m][1];
                    u32x4 w; w.x = cvt_pk_bf16(v0[0], v0[1]); w.y = cvt_pk_bf16(v0[2], v0[3]); w.z = cvt_pk_bf16(v1[0], v1[1]); w.w = cvt_pk_bf16(v1[2], v1[3]);
                    *(u32x4*)(out + row * (2 * D) + col0 + bj * 128) = w; } }
    }
};
struct EpiHid {
    static constexpr bool PERM = true;
    unsigned char* hid;
    __device__ __forceinline__ void operator()(const f32x4 (&acc)[2][2][4][2], const Unit& u, int wr, int wc, int fr, int fq) const {
        const int row0 = u.pm * 256 + wr * 64 + fr, col0 = (u.pn & 15) * 128 + wc * 32 + 8 * fq;
#pragma unroll
        for (int ai = 0; ai < 2; ++ai)
#pragma unroll
            for (int m = 0; m < 4; ++m) { const f32x4 g0 = acc[ai][0][m][0], g1 = acc[ai][0][m][1], u0 = acc[ai][1][m][0], u1 = acc[ai][1][m][1];
                constexpr float SI = 1.f / (SC_H8 * SC_W8), SO = SC_HID8 / (SC_H8 * SC_W8);
                u32x2 w; w.x = pk4_f8(siluf(g0[0] * SI) * (u0[0] * SO), siluf(g0[1] * SI) * (u0[1] * SO), siluf(g0[2] * SI) * (u0[2] * SO), siluf(g0[3] * SI) * (u0[3] * SO));
                w.y = pk4_f8(siluf(g1[0] * SI) * (u1[0] * SO), siluf(g1[1] * SI) * (u1[1] * SO), siluf(g1[2] * SI) * (u1[2] * SO), siluf(g1[3] * SI) * (u1[3] * SO));
                unsigned off = (unsigned)(row0 + ai * 128 + m * 16) * FF + col0; asm volatile("" : "+v"(off));
                *(u32x2*)(hid + off) = w; }
    }
};
struct EpiYe {
    static constexpr bool PERM = true;
    const float* gate; unsigned char* ye;
    __device__ __forceinline__ void operator()(const f32x4 (&acc)[2][2][4][2], const Unit& u, int wr, int wc, int fr, int fq) const {
        const int row0 = u.pm * 256 + wr * 64 + fr, col0 = (u.pn & 3) * 256 + wc * 32 + 8 * fq;
#pragma unroll
        for (int ai = 0; ai < 2; ++ai)
#pragma unroll
            for (int m = 0; m < 4; ++m) { const int row = row0 + ai * 128 + m * 16; const float gt = gate[row] * (SC_YE8 / (SC_HID8 * SC_W8));
#pragma unroll
                for (int bj = 0; bj < 2; ++bj) { const f32x4 v0 = acc[ai][bj][m][0] * gt, v1 = acc[ai][bj][m][1] * gt;
                    u32x2 w; w.x = pk4_f8(v0[0], v0[1], v0[2], v0[3]); w.y = pk4_f8(v1[0], v1[1], v1[2], v1[3]);
                    unsigned off = (unsigned)row * D + col0 + bj * 128; asm volatile("" : "+v"(off));
                    *(u32x2*)(ye + off) = w; } }
    }
};

constexpr int T64S = 136;
__device__ __forceinline__ void t64_load(f32x4 (&v)[16], const float* src, int ld_src, int lane) {
#pragma unroll
    for (int x = 0; x < 16; ++x) v[x] = __builtin_nontemporal_load((const f32x4*)(src + (size_t)(4 * x + (lane >> 4)) * ld_src + 4 * (lane & 15)));
}
__device__ __forceinline__ void t64_store(const f32x4 (&v)[16], bf16_t* dst, int ld_dst, LAS unsigned char* tile, int lane) {
#pragma unroll
    for (int x = 0; x < 16; ++x) { u32x2 w; w.x = pk2(v[x].x, v[x].y); w.y = pk2(v[x].z, v[x].w); *(LAS u32x2*)(tile + (4 * x + (lane >> 4)) * T64S + 8 * (lane & 15)) = w; }
    LDS_WAIT(); asm volatile("" ::: "memory");
    const int i = lane & 15, grp = lane >> 4, q = i >> 2, p = i & 3;
#pragma unroll
    for (int y = 0; y < 8; ++y) { const int n0 = 16 * (y & 3), kc = grp + 4 * (y >> 2);
        const LAS unsigned char* tp = tile + (8 * kc + q) * T64S + (n0 + 4 * p) * 2;
        typedef short v4i16_t __attribute__((ext_vector_type(4)));
        const v4i16_t lo = __builtin_amdgcn_ds_read_tr16_b64_v4i16((LAS v4i16_t*)tp), hi = __builtin_amdgcn_ds_read_tr16_b64_v4i16((LAS v4i16_t*)(tp + 4 * T64S));
        const bf16x8 o = (bf16x8){lo[0], lo[1], lo[2], lo[3], hi[0], hi[1], hi[2], hi[3]};
        *(GAS bf16x8*)(dst + (size_t)(n0 + i) * ld_dst + 8 * kc) = o; }
    LDS_WAIT(); asm volatile("" ::: "memory");
}
__device__ __forceinline__ void e8_load(f32x4 (&v)[16], const float* src, int ld_src, int lane) {
#pragma unroll
    for (int x = 0; x < 16; ++x) v[x] = __builtin_nontemporal_load((const f32x4*)(src + (size_t)(16 * (lane >> 4) + x) * ld_src + 4 * (lane & 15)));
}
__device__ __forceinline__ void e8_store(const f32x4 (&v)[16], unsigned char* dst, int ld_dst, int lane) {
#pragma unroll
    for (int i = 0; i < 4; ++i) { u32x4 w;
        w.x = pk4_f8(v[0][i] * SC_W8, v[1][i] * SC_W8, v[2][i] * SC_W8, v[3][i] * SC_W8); w.y = pk4_f8(v[4][i] * SC_W8, v[5][i] * SC_W8, v[6][i] * SC_W8, v[7][i] * SC_W8);
        w.z = pk4_f8(v[8][i] * SC_W8, v[9][i] * SC_W8, v[10][i] * SC_W8, v[11][i] * SC_W8); w.w = pk4_f8(v[12][i] * SC_W8, v[13][i] * SC_W8, v[14][i] * SC_W8, v[15][i] * SC_W8);
        *(u32x4*)(dst + (size_t)(4 * (lane & 15) + i) * ld_dst + 16 * (lane >> 4)) = w; }
}
__device__ __forceinline__ void econv_addr(Frame& F, int it, const float*& src, int& ld_src, unsigned char*& dst, int& ld_dst) {
    unsigned char* WGU = F.ws + WS_WGU; unsigned char* WD = F.ws + WS_WD;
    const int which = it >> 13, r = it & 8191, e = r >> 9, q = r & 511;
    if (which < 2) { const int kb = q >> 5, nb = q & 31, n0 = nb * 64; const int drow = (n0 >> 7) * 256 + which * 128 + (n0 & 127);
        src = F.in[which ? I_EWU : I_EWG] + (size_t)e * D * FF + (size_t)(kb * 64) * FF + n0; ld_src = FF; dst = WGU + ((size_t)e * 4096 + drow) * D + kb * 64; ld_dst = D; }
    else { const int kb = q >> 4, nb = q & 15;
        src = F.in[I_EWD] + (size_t)e * FF * D + (size_t)(kb * 64) * D + nb * 64; ld_src = D; dst = WD + ((size_t)e * D + nb * 64) * FF + kb * 64; ld_dst = FF; }
}
__device__ __forceinline__ void econv_drain(Frame& F, unsigned* ctr, int item0, int nitems) {
    constexpr int BATCH = 4;
    for (;;) {
        unsigned base = 0u; if (F.lane == 0) base = atomicAdd(ctr, (unsigned)BATCH);
        base = (unsigned)__builtin_amdgcn_readfirstlane(base);
        if (base >= (unsigned)nitems) break;
        const float* src; int ls; unsigned char* dst; int ld; f32x4 va[16], vb[16];
        econv_addr(F, item0 + (int)base, src, ls, dst, ld); e8_load(va, src, ls, F.lane);
#pragma unroll 1
        for (int j = 0; j < BATCH; j += 2) {
            const float* src2; int ls2; unsigned char* dst2; int ld2; const bool ok2 = (int)base + j + 1 < nitems;
            if (ok2) { econv_addr(F, item0 + (int)base + j + 1, src2, ls2, dst2, ld2); e8_load(vb, src2, ls2, F.lane); }
            e8_store(va, dst, ld, F.lane);
            if (j + 2 < BATCH && (int)base + j + 2 < nitems) { econv_addr(F, item0 + (int)base + j + 2, src, ls, dst, ld); e8_load(va, src, ls, F.lane); }
            if (ok2) e8_store(vb, dst2, ld2, F.lane);
            if ((int)base + j + 2 >= nitems) break;
        }
    }
}
__device__ __forceinline__ void econv_queue(Frame& F) {
    unsigned* ctl = (unsigned*)(F.ws + WS_CTL);
#pragma unroll 1
    for (int qi = 0; qi < 2; ++qi)
        econv_drain(F, ctl + (qi ? CW_QUEUE : CW_QUEUE2), qi ? 0 : 16384 + 7168, qi ? 16384 : 1024);
}

__device__ __forceinline__ void ph_prologue(Frame& F) {
    float* MOD = (float*)(F.ws + WS_MOD);
    if (F.bid < 192) {
        LAS float* sc = (LAS float*)F.lds; LAS float* red = (LAS float*)(F.lds + 20480);
        for (int i = F.tid; i < 5 * D; i += NTHR) { const int r = i >> 10, k = i & 1023; const float cv = (r < 4) ? F.in[I_C][r * D + k] : F.in[I_CCTX][k]; sc[i] = siluf(cv); }
        __syncthreads();
        for (int item = F.bid; item < 192; item += F.G) {
            const int n0 = item * 32, nn = F.tid & 31, kg = F.tid >> 5;
            float a[5] = {0.f, 0.f, 0.f, 0.f, 0.f};
            const float* w = F.in[I_ADAW] + (size_t)(kg * 64) * (NMOD * D) + n0 + nn;
#pragma unroll 8
            for (int kk = 0; kk < 64; ++kk) { const float wv = w[(size_t)kk * (NMOD * D)];
#pragma unroll
                for (int r = 0; r < 5; ++r) a[r] += sc[r * D + kg * 64 + kk] * wv; }
#pragma unroll
            for (int r = 0; r < 5; ++r) red[(kg * 5 + r) * 32 + nn] = a[r];
            __syncthreads();
            if (F.tid < 160) { const int r = F.tid >> 5, n2 = F.tid & 31; float s = F.in[I_ADAB][n0 + n2];
                for (int k2 = 0; k2 < 16; ++k2) s += red[(k2 * 5 + r) * 32 + n2];
                MOD[r * (NMOD * D) + n0 + n2] = s; }
            __syncthreads();
        }
    }
    if (F.bid == F.G - 1) {
        float* LB = (float*)(F.ws + WS_LB);
        for (int i = F.tid; i < 1024; i += NTHR) { const int dir = i >> 9, c = i & 511; const float l0 = F.in[I_LBL][dir * 1024 + c], l1 = F.in[I_LBL][dir * 1024 + 512 + c]; LB[i] = 1.f / (1.f + __expf(l1 - l0)); }
    }
    __syncthreads();
    LAS unsigned char* tile = F.lds + F.wave * 16384;
    const int gw = F.vcu * NWAVES + F.wave, NGW = F.G * NWAVES;
    bf16_t* WIN = (bf16_t*)(F.ws + WS_WIN); bf16_t* WA = (bf16_t*)(F.ws + WS_WA); bf16_t* WB = (bf16_t*)(F.ws + WS_WB); bf16_t* WO = (bf16_t*)(F.ws + WS_WO);
    for (int it = gw; it < 1920; it += NGW) {
        int r = it; f32x4 v[16];
        if (r < 1408) { const int kb = r / 88, nb = r % 88;
            if (nb >= 56) { e8_load(v, F.in[I_WIN] + (size_t)(kb * 64) * INC + nb * 64, INC, F.lane); e8_store(v, F.ws + WS_W8 + (size_t)((nb - 56) * 64) * D + kb * 64, D, F.lane); continue; }
            t64_load(v, F.in[I_WIN] + (size_t)(kb * 64) * INC + nb * 64, INC, F.lane); t64_store(v, WIN + (size_t)(nb * 64) * D + kb * 64, D, tile, F.lane); continue; } r -= 1408;
        if (r < 128) { const int kb = r / 16, nb = r % 16; t64_load(v, F.in[I_WBA] + (size_t)(kb * 64) * D + nb * 64, D, F.lane); t64_store(v, WA + (size_t)(nb * 64) * D + kb * 64, D, tile, F.lane); continue; } r -= 128;
        if (r < 128) { const int kb = r / 16, nb = r % 16; t64_load(v, F.in[I_WBB] + (size_t)(kb * 64) * D + nb * 64, D, F.lane); t64_store(v, WA + (size_t)(nb * 64) * D + 512 + kb * 64, D, tile, F.lane); continue; } r -= 128;
        { const int kb = r / 16, nb = r % 16; t64_load(v, F.in[I_WOUT] + (size_t)(kb * 64) * D + nb * 64, D, F.lane); t64_store(v, WO + (size_t)(nb * 64) * D + kb * 64, D, tile, F.lane); }
    }
}

__device__ __forceinline__ void ph_norm1(Frame& F) {
    const float* MOD = (const float*)(F.ws + WS_MOD); bf16_t* H = (bf16_t*)(F.ws + WS_H); unsigned char* H8 = F.ws + WS_H8;
    const int gw = F.vcu * NWAVES + F.wave, NGW = F.G * NWAVES;
    int curb = -1; f32x4 ca[4], cb[4];
    for (int m = gw; m < MT; m += NGW) {
        const int b = m < ML ? m / T : 4;
        if (b != curb) { curb = b;
#pragma unroll
            for (int j = 0; j < 4; ++j) { const int col = 4 * F.lane + 256 * j; const f32x4 w4 = *(const f32x4*)(F.in[I_NMIX] + col), s4 = *(const f32x4*)(MOD + b * (NMOD * D) + D + col);
                ca[j] = w4 * (s4 + 1.f); cb[j] = *(const f32x4*)(MOD + b * (NMOD * D) + col); } }
        const float* xr = m < ML ? F.in[I_X] + (size_t)m * D : F.in[I_CTX] + (size_t)(m - ML) * D;
        f32x4 v[4]; float ss = 0.f;
#pragma unroll
        for (int j = 0; j < 4; ++j) { v[j] = __builtin_nontemporal_load((const f32x4*)(xr + 4 * F.lane + 256 * j)); ss += (v[j].x * v[j].x + v[j].y * v[j].y) + (v[j].z * v[j].z + v[j].w * v[j].w); }
        const float rstd = rsqrtf(wave_sum(ss) * (1.f / D) + EPS);
#pragma unroll
        for (int j = 0; j < 4; ++j) { const f32x4 o = v[j] * rstd * ca[j] + cb[j]; u32x2 w; w.x = pk2(o.x, o.y); w.y = pk2(o.z, o.w);
            *(u32x2*)(H + (size_t)m * D + 4 * F.lane + 256 * j) = w;
            if (m < ML) *(unsigned*)(H8 + (size_t)m * D + 4 * F.lane + 256 * j) = pk4_f8(o.x * SC_H8, o.y * SC_H8, o.z * SC_H8, o.w * SC_H8); }
    }
}

namespace hg {
constexpr int TS = 136, TILE_B = 64 * TS * 2;
constexpr int OFF_QT = 0, OFF_KT = TILE_B, OFF_VT = 2 * TILE_B, OFF_EM = 3 * TILE_B, OFF_D2 = OFF_EM + 512, BUF_B = 3 * TILE_B + 1024;
constexpr int PS = 72, OFF_P = 2 * BUF_B, OFF_TOT = OFF_P + 64 * PS * 2;
static_assert(OFF_TOT + 2048 <= RING_BYTES, "hg LDS map");
typedef short v4i16_t __attribute__((ext_vector_type(4)));
__device__ __forceinline__ v4i16_t trd(const LAS unsigned char* p) { return __builtin_amdgcn_ds_read_tr16_b64_v4i16((LAS v4i16_t*)p); }
__device__ __forceinline__ bf16x8 cat8(v4i16_t lo, v4i16_t hi) { return (bf16x8){lo[0], lo[1], lo[2], lo[3], hi[0], hi[1], hi[2], hi[3]}; }
#define HG_BAR_LDS() do { asm volatile("s_waitcnt lgkmcnt(0)" ::: "memory"); __builtin_amdgcn_s_barrier(); asm volatile("" ::: "memory"); } while (0)
struct Raw { unsigned lf[16], q[16]; u32x4 v[4]; };
struct PSt { int unused; };

template <bool OUT>
__device__ __forceinline__ void load_raw(Frame& F, Raw& R, const bf16_t* Qb, const bf16_t* Fb, const bf16_t* Vb, int rowbase, int len, int dir, int p0, int h, int pw) {
    asm volatile("" : "+v"(p0));
#pragma unroll
    for (int i = 0; i < 16; ++i) { const int p = p0 + 16 * pw + i, tok = dir ? len - 1 - p : p; const size_t off = (size_t)(rowbase + tok) * HW + h * DK + 2 * F.lane;
        R.lf[i] = *(const unsigned*)(Fb + off); if (OUT) R.q[i] = *(const unsigned*)(Qb + off); }
    { const int pt = F.lane + 64 * pw, r = pt >> 2, qd = pt & 3, p = p0 + r, tok = dir ? len - 1 - p : p; const bf16_t* vp = Vb + (size_t)(rowbase + tok) * HW + h * DK + qd * 32;
#pragma unroll
      for (int x = 0; x < 4; ++x) R.v[x] = *(const u32x4*)(vp + 8 * x); }
}
__device__ __forceinline__ void prep1(Frame& F, const Raw& R, LAS unsigned char* buf, int pw, PSt& P) {
    LAS float* TOT = (LAS float*)(F.lds + OFF_TOT);
    float a0 = 0.f, a1 = 0.f;
#pragma unroll
    for (int i = 0; i < 16; ++i) { a0 += bflo(R.lf[i]); a1 += bfhi(R.lf[i]); }
    *(LAS f32x2*)(TOT + pw * 128 + 2 * F.lane) = (f32x2){a0, a1};
    { const int pt = F.lane + 64 * pw, r = pt >> 2, qd = pt & 3;
#pragma unroll
      for (int x = 0; x < 4; ++x) *(LAS u32x4*)(buf + OFF_VT + (r * TS + qd * 32 + 8 * x) * 2) = R.v[x]; }
}
template <bool OUT>
__device__ __forceinline__ void prep2(Frame& F, const Raw& R, LAS unsigned char* buf, int pw, const PSt& P, float& seg0, float& seg1) {
    const LAS float* TOT = (const LAS float*)(F.lds + OFF_TOT);
    float off0 = 0.f, off1 = 0.f, m0 = 0.f, m1 = 0.f, t0 = 0.f, t1 = 0.f, own0 = 0.f, own1 = 0.f;
#pragma unroll
    for (int g2 = 0; g2 < 4; ++g2) { const f32x2 t = *(const LAS f32x2*)(TOT + g2 * 128 + 2 * F.lane);
        if (g2 < pw) { off0 += t.x; off1 += t.y; } if (g2 == pw) { own0 = t.x; own1 = t.y; } if (g2 < 2) { m0 += t.x; m1 += t.y; } t0 += t.x; t1 += t.y; }
    float f0[16], f1[16];
    float E0 = __expf(fminf(off0 - m0, 80.f)), E1 = __expf(fminf(off1 - m1, 80.f));
#pragma unroll
    for (int i = 0; i < 16; ++i) { f0[i] = __expf(bflo(R.lf[i])); f1[i] = __expf(bfhi(R.lf[i])); E0 *= f0[i]; E1 *= f1[i];
        if (OUT) *(LAS unsigned*)(buf + OFF_QT + ((16 * pw + i) * TS + 2 * F.lane) * 2) = cvt_pk_bf16(bflo(R.q[i]) * E0, bfhi(R.q[i]) * E1); }
    float G0 = __expf(fminf(m0 - (off0 + own0), 80.f)), G1 = __expf(fminf(m1 - (off1 + own1), 80.f));
#pragma unroll
    for (int i = 15; i >= 0; --i) { *(LAS unsigned*)(buf + OFF_KT + ((16 * pw + i) * TS + 2 * F.lane) * 2) = cvt_pk_bf16((1.f - f0[i]) * G0, (1.f - f1[i]) * G1); G0 *= f0[i]; G1 *= f1[i]; }
    if (pw == 0) { *(LAS f32x2*)(buf + OFF_EM + 8 * F.lane) = (f32x2){__expf(m0), __expf(m1)}; *(LAS f32x2*)(buf + OFF_D2 + 8 * F.lane) = (f32x2){__expf(t0 - m0), __expf(t1 - m1)}; }
    seg0 += t0; seg1 += t1;
}
__device__ __forceinline__ void p_tile(Frame& F, const LAS unsigned char* buf, int it, int jt) {
    const int c = F.lane & 15, g = F.lane >> 4;
    f32x4 acc = (f32x4){0.f, 0.f, 0.f, 0.f};
    bf16x8 a[4], b[4];
#pragma unroll
    for (int s = 0; s < 4; ++s) { a[s] = *(const LAS bf16x8*)(buf + OFF_KT + ((16 * jt + c) * TS + 32 * s + 8 * g) * 2); b[s] = *(const LAS bf16x8*)(buf + OFF_QT + ((16 * it + c) * TS + 32 * s + 8 * g) * 2); }
#pragma unroll
    for (int s = 0; s < 4; ++s) acc = __builtin_amdgcn_mfma_f32_16x16x32_bf16(a[s], b[s], acc, 0, 0, 0);
    if (it == jt) {
#pragma unroll
        for (int r = 0; r < 4; ++r) acc[r] = (4 * g + r > c) ? 0.f : acc[r]; }
    u32x2 wv; wv.x = cvt_pk_bf16(acc[0], acc[1]); wv.y = cvt_pk_bf16(acc[2], acc[3]);
    *(LAS u32x2*)(F.lds + OFF_P + ((16 * it + c) * PS + 16 * jt + 4 * g) * 2) = wv;
}
__device__ __forceinline__ void tile_of(int idx, int& it, int& jt) { it = (idx >= 6) ? 3 : (idx >= 3) ? 2 : (idx >= 1) ? 1 : 0; jt = idx - it * (it + 1) / 2; }
__device__ __forceinline__ void m_part1(Frame& F, const LAS unsigned char* buf, int mw, f32x4 (&S)[2][8], f32x4 (&oT)[2][4], bf16x8 (&vf)[2][2]) {
    const int c = F.lane & 15, g = F.lane >> 4;
    { int it, jt; tile_of(mw, it, jt); p_tile(F, buf, it, jt); asm volatile("" ::: "memory"); tile_of(mw + 4, it, jt); p_tile(F, buf, it, jt); asm volatile("" ::: "memory"); if (mw < 2) { tile_of(mw + 8, it, jt); p_tile(F, buf, it, jt); } asm volatile("" ::: "memory"); }
#pragma unroll
    for (int vs = 0; vs < 2; ++vs)
#pragma unroll
        for (int it = 0; it < 4; ++it) oT[vs][it] = (f32x4){0.f, 0.f, 0.f, 0.f};
#pragma unroll
    for (int s = 0; s < 4; ++s) {
        bf16x8 af[2], bq[4];
#pragma unroll
        for (int it = 0; it < 4; ++it) { const LAS unsigned char* qp = buf + OFF_QT + ((16 * it + c) * TS + 32 * s + 4 * g) * 2;
            const u32x2 lo = *(const LAS u32x2*)qp, hi = *(const LAS u32x2*)(qp + 32); bq[it] = __builtin_bit_cast(bf16x8, (u32x4){lo.x, lo.y, hi.x, hi.y}); }
#pragma unroll
        for (int vs = 0; vs < 2; ++vs) { u32x4 aw; aw.x = cvt_pk_bf16(S[vs][2 * s][0], S[vs][2 * s][1]); aw.y = cvt_pk_bf16(S[vs][2 * s][2], S[vs][2 * s][3]); aw.z = cvt_pk_bf16(S[vs][2 * s + 1][0], S[vs][2 * s + 1][1]); aw.w = cvt_pk_bf16(S[vs][2 * s + 1][2], S[vs][2 * s + 1][3]);
            af[vs] = __builtin_bit_cast(bf16x8, aw); }
#pragma unroll
        for (int it = 0; it < 4; ++it) {
            oT[0][it] = __builtin_amdgcn_mfma_f32_16x16x32_bf16(af[0], bq[it], oT[0][it], 0, 0, 0);
            oT[1][it] = __builtin_amdgcn_mfma_f32_16x16x32_bf16(af[1], bq[it], oT[1][it], 0, 0, 0); }
        asm volatile("" ::: "memory");
    }
    const int trow = 8 * g + (c >> 2), tcol = 4 * (c & 3);
#pragma unroll
    for (int vs = 0; vs < 2; ++vs)
#pragma unroll
        for (int js = 0; js < 2; ++js) { const LAS unsigned char* vp = buf + OFF_VT + ((32 * js + trow) * TS + 32 * mw + 16 * vs + tcol) * 2; vf[vs][js] = cat8(trd(vp), trd(vp + 4 * TS * 2)); }
    { bf16x8 kf[8];
#pragma unroll
      for (int t = 0; t < 8; ++t) { const LAS unsigned char* kp = buf + OFF_KT + (trow * TS + 16 * t + tcol) * 2; kf[t] = cat8(trd(kp), trd(kp + 4 * TS * 2)); }
#pragma unroll
      for (int t = 0; t < 8; ++t) {
          S[0][t] = __builtin_amdgcn_mfma_f32_16x16x32_bf16(kf[t], vf[0][0], S[0][t], 0, 0, 0);
          S[1][t] = __builtin_amdgcn_mfma_f32_16x16x32_bf16(kf[t], vf[1][0], S[1][t], 0, 0, 0); } }
}
template <bool OUT>
__device__ __forceinline__ void m_part2(Frame& F, const LAS unsigned char* buf, int mw, f32x4 (&S)[2][8], f32x4 (&oT)[2][4], bf16x8 (&vf)[2][2]) {
    const int c = F.lane & 15, g = F.lane >> 4;
    const int trow = 8 * g + (c >> 2), tcol = 4 * (c & 3);
    if (!OUT) {
#pragma unroll
        for (int vs = 0; vs < 2; ++vs)
#pragma unroll
            for (int js = 0; js < 2; ++js) { const LAS unsigned char* vp = buf + OFF_VT + ((32 * js + trow) * TS + 32 * mw + 16 * vs + tcol) * 2; vf[vs][js] = cat8(trd(vp), trd(vp + 4 * TS * 2)); }
    }
    if (OUT) {
        bf16x8 pb[4][2];
#pragma unroll
        for (int it = 0; it < 4; ++it)
#pragma unroll
            for (int js = 0; js < 2; ++js) if (32 * js <= 16 * it + 15) pb[it][js] = *(const LAS bf16x8*)(F.lds + OFF_P + ((16 * it + c) * PS + 32 * js + 8 * g) * 2);
#pragma unroll
        for (int it = 0; it < 4; ++it)
#pragma unroll
            for (int js = 0; js < 2; ++js) if (32 * js <= 16 * it + 15) {
                oT[0][it] = __builtin_amdgcn_mfma_f32_16x16x32_bf16(vf[0][js], pb[it][js], oT[0][it], 0, 0, 0);
                oT[1][it] = __builtin_amdgcn_mfma_f32_16x16x32_bf16(vf[1][js], pb[it][js], oT[1][it], 0, 0, 0); }
    }
    constexpr int TB = 8;
#pragma unroll
    for (int js = OUT ? 1 : 0; js < 2; ++js)
#pragma unroll
        for (int t0 = 0; t0 < 8; t0 += TB) {
            bf16x8 kf[TB];
#pragma unroll
            for (int t = 0; t < TB; ++t) { const LAS unsigned char* kp = buf + OFF_KT + ((32 * js + trow) * TS + 16 * (t0 + t) + tcol) * 2; kf[t] = cat8(trd(kp), trd(kp + 4 * TS * 2)); }
#pragma unroll
            for (int t = 0; t < TB; ++t) {
                S[0][t0 + t] = __builtin_amdgcn_mfma_f32_16x16x32_bf16(kf[t], vf[0][js], S[0][t0 + t], 0, 0, 0);
                S[1][t0 + t] = __builtin_amdgcn_mfma_f32_16x16x32_bf16(kf[t], vf[1][js], S[1][t0 + t], 0, 0, 0); }
            asm volatile("" ::: "memory");
        }
}
__device__ __forceinline__ void m_scale(Frame& F, const LAS unsigned char* buf, const LAS unsigned char* bufprev, bool hasprev, f32x4 (&S)[2][8]) {
    const int g = F.lane >> 4;
    f32x4 e4[8];
#pragma unroll
    for (int t = 0; t < 8; ++t) e4[t] = *(const LAS f32x4*)(buf + OFF_EM + (16 * t + 4 * g) * 4);
    if (hasprev) {
#pragma unroll
        for (int t = 0; t < 8; ++t) e4[t] *= *(const LAS f32x4*)(bufprev + OFF_D2 + (16 * t + 4 * g) * 4); }
#pragma unroll
    for (int t = 0; t < 8; ++t) { S[0][t] *= e4[t]; S[1][t] *= e4[t]; }
}
__device__ __forceinline__ void m_final_scale(Frame& F, const LAS unsigned char* buf, f32x4 (&S)[2][8]) {
    const int g = F.lane >> 4;
#pragma unroll
    for (int t = 0; t < 8; ++t) { const f32x4 d4 = *(const LAS f32x4*)(buf + OFF_D2 + (16 * t + 4 * g) * 4); S[0][t] *= d4; S[1][t] *= d4; }
}
__device__ __forceinline__ size_t st_idx(int mw, int vs, int t, int lane) { return (size_t)((((mw * 2 + vs) * 8 + t) * 64 + lane) * 4); }

struct ConvSt { f32x4 v[16]; unsigned char* dst; int ld; int have; };
__device__ __forceinline__ void conv_issue(Frame& F, ConvSt& C, int idx) {
    C.have = (idx >= 0 && idx < 8192) ? 1 : 0;
    if (C.have) { const float* src; int ls; econv_addr(F, 16384 + idx, src, ls, C.dst, C.ld); e8_load(C.v, src, ls, F.lane); }
}
__device__ __forceinline__ void conv_finish(Frame& F, ConvSt& C) { if (C.have) { e8_store(C.v, C.dst, C.ld, F.lane); C.have = 0; } }
template <bool OUT>
__device__ __forceinline__ void scan_item(Frame& F, int item) {
    const int seq = item >> 3, part = item & 7, b = seq >> 3, h = (seq >> 1) & 3, dir = seq & 1;
    const bool isctx = !OUT && part == 0;
    const int len = isctx ? CTXL : T, rowbase = isctx ? ML + b * CTXL : b * T, nch = isctx ? 4 : 16, pbeg = OUT ? part * 1024 : (isctx ? 0 : (part - 1) * 1024);
    const bf16_t* Qb = (const bf16_t*)(F.ws + WS_Q); const bf16_t* Fb = (const bf16_t*)(F.ws + (dir ? WS_FB : WS_FF)); const bf16_t* Vb = (const bf16_t*)(F.ws + WS_V);
    bf16_t* OD = (bf16_t*)(F.ws + WS_ODIR) + (size_t)dir * ML * HW;
    const bool isP = F.wave >= 4; const int pw = F.wave & 3, mw = F.wave & 3;
    const int c = F.lane & 15, g = F.lane >> 4;
    f32x4 S[2][8], oT[2][4];
    Raw RA, RB; PSt PS_;
    float seg0 = 0.f, seg1 = 0.f;
    if (isP) { load_raw<OUT>(F, RA, Qb, Fb, Vb, rowbase, len, dir, pbeg, h, pw); }
    else {
        if (OUT) {
            const float* ST = (const float*)(F.ws + WS_STATE) + (size_t)(seq * 8 + part) * 16384;
#pragma unroll
            for (int vs = 0; vs < 2; ++vs)
#pragma unroll
                for (int t = 0; t < 8; ++t) S[vs][t] = *(const f32x4*)(ST + st_idx(mw, vs, t, F.lane));
            { const int half = F.tid >> 7, q = F.tid & 127, row = (half ? 32 : 0) + (q >> 3), col = (half ? 48 : 16) + 2 * (q & 7); *(LAS unsigned*)(F.lds + OFF_P + (row * PS + col) * 2) = 0u; }
        } else {
#pragma unroll
            for (int vs = 0; vs < 2; ++vs)
#pragma unroll
                for (int t = 0; t < 8; ++t) S[vs][t] = (f32x4){0.f, 0.f, 0.f, 0.f};
        }
    }
    if (isP) {
#define HG_P_PERIOD(RCUR, RNXT, n_) do { const int pn_ = (n_); LAS unsigned char* bufp = F.lds + (pn_ & 1) * BUF_B; \
            if (pn_ + 1 < nch) load_raw<OUT>(F, RNXT, Qb, Fb, Vb, rowbase, len, dir, pbeg + 64 * (pn_ + 1), h, pw); \
            if (pn_ < nch) prep1(F, RCUR, bufp, pw, PS_); \
            HG_BAR_LDS(); \
            if (pn_ < nch) prep2<OUT>(F, RCUR, bufp, pw, PS_, seg0, seg1); \
            HG_BAR_LDS(); } while (0)
        for (int n = 0; n <= nch; n += 2) { HG_P_PERIOD(RA, RB, n); if (n + 1 <= nch) HG_P_PERIOD(RB, RA, n + 1); }
#undef HG_P_PERIOD
    } else {
        ConvSt CV; CV.have = 0; CV.dst = nullptr; CV.ld = 0; bf16x8 vfm[2][2];
        for (int n = 0; n <= nch; ++n) {
            const LAS unsigned char* bufm = F.lds + ((n - 1) & 1) * BUF_B;
            if (!OUT) { conv_finish(F, CV); conv_issue(F, CV, (!isctx && (n & 1) && n < 16) ? ((seq * 7 + part - 1) * 4 + mw) * 8 + (n >> 1) : -1); }
            if (n >= 1) m_scale(F, bufm, F.lds + (n & 1) * BUF_B, n >= 2, S);
            if (OUT && n >= 1) m_part1(F, bufm, mw, S, oT, vfm);
            HG_BAR_LDS();
            if (n >= 1) { m_part2<OUT>(F, bufm, mw, S, oT, vfm);
                if (OUT) {
#pragma unroll
                    for (int vs = 0; vs < 2; ++vs)
#pragma unroll
                        for (int it = 0; it < 4; ++it) { const int p = pbeg + 64 * (n - 1) + 16 * it + c, tok = dir ? T - 1 - p : p;
                            u32x2 wv; wv.x = cvt_pk_bf16(oT[vs][it][0], oT[vs][it][1]); wv.y = cvt_pk_bf16(oT[vs][it][2], oT[vs][it][3]);
                            *(u32x2*)(OD + (size_t)(rowbase + tok) * HW + h * DK + 32 * mw + 16 * vs + 4 * g) = wv; } } }
            HG_BAR_LDS();
        }
        if (!OUT) { conv_finish(F, CV); m_final_scale(F, F.lds + ((nch - 1) & 1) * BUF_B, S); }
    }
    if (!OUT) {
        float* ST = (float*)(F.ws + WS_STATE) + (size_t)item * 16384; float* DC = (float*)(F.ws + WS_DEC) + item * 128;
        if (!isP) {
#pragma unroll
            for (int vs = 0; vs < 2; ++vs)
#pragma unroll
                for (int t = 0; t < 8; ++t) *(f32x4*)(ST + st_idx(mw, vs, t, F.lane)) = S[vs][t]; }
        else if (pw == 0) { DC[2 * F.lane] = __expf(seg0); DC[2 * F.lane + 1] = __expf(seg1); }
    }
    HG_BAR_LDS();
}
}

__device__ __forceinline__ void ph_sgu(Frame& F) {
    constexpr int TS = hg::TS; constexpr int OFF_W = 0, OFF_VN = 128 * TS * 2;
    const int g4 = F.bid & 3, c = F.lane & 15, g = F.lane >> 4, w = F.wave;
    const bf16_t* VS = (const bf16_t*)(F.ws + WS_VS); const bf16_t* U = (const bf16_t*)(F.ws + WS_U); bf16_t* AC = (bf16_t*)(F.ws + WS_H);
    { const float* wsrc = F.in[I_SGUW] + (size_t)g4 * 16384;
#pragma unroll
      for (int x = 0; x < 8; ++x) { const int id = F.tid + NTHR * x, row = id >> 5, c4 = id & 31; const f32x4 v = *(const f32x4*)(wsrc + row * 128 + 4 * c4);
          u32x2 o; o.x = pk2(v.x, v.y); o.y = pk2(v.z, v.w); *(LAS u32x2*)(F.lds + OFF_W + (row * TS + 4 * c4) * 2) = o; } }
    for (int bn = (F.bid >> 2); bn < NB * 64; bn += (F.G >> 2)) {
        const int b = bn >> 6, n = bn & 63, rowbase = b * T + n * 128;
        __syncthreads();
        { const int s = F.tid >> 2, part = F.tid & 3; const bf16_t* src = VS + (size_t)(rowbase + s) * SW + g4 * 128 + part * 32;
          float v[32]; float ss = 0.f;
#pragma unroll
          for (int q = 0; q < 4; ++q) { const u32x4 w4 = *(const u32x4*)(src + q * 8); const unsigned ww[4] = {w4.x, w4.y, w4.z, w4.w};
#pragma unroll
              for (int e = 0; e < 4; ++e) { v[q * 8 + 2 * e] = bflo(ww[e]); v[q * 8 + 2 * e + 1] = bfhi(ww[e]); } }
#pragma unroll
          for (int e = 0; e < 32; ++e) ss += v[e] * v[e];
          ss += __shfl_xor(ss, 1); ss += __shfl_xor(ss, 2);
          const float rstd = rsqrtf(ss * (1.f / 128.f) + EPS);
          const float* nw = F.in[I_SNW] + g4 * 128 + part * 32;
#pragma unroll
          for (int q = 0; q < 4; ++q) { u32x4 o; unsigned ow[4];
#pragma unroll
              for (int e = 0; e < 4; ++e) ow[e] = pk2(v[q * 8 + 2 * e] * rstd * nw[q * 8 + 2 * e], v[q * 8 + 2 * e + 1] * rstd * nw[q * 8 + 2 * e + 1]);
              o.x = ow[0]; o.y = ow[1]; o.z = ow[2]; o.w = ow[3];
              *(LAS u32x4*)(F.lds + OFF_VN + (s * TS + part * 32 + q * 8) * 2) = o; } }
        __syncthreads();
        f32x4 acc[8];
#pragma unroll
        for (int ct = 0; ct < 8; ++ct) acc[ct] = (f32x4){0.f, 0.f, 0.f, 0.f};
#pragma unroll
        for (int ks = 0; ks < 4; ++ks) {
            const bf16x8 bw = *(const LAS bf16x8*)(F.lds + OFF_W + ((16 * w + c) * TS + 32 * ks + 8 * g) * 2);
#pragma unroll
            for (int ct = 0; ct < 8; ++ct) { const LAS unsigned char* vp = F.lds + OFF_VN + ((32 * ks + 8 * g + (c >> 2)) * TS + 16 * ct + 4 * (c & 3)) * 2;
                acc[ct] = __builtin_amdgcn_mfma_f32_16x16x32_bf16(hg::cat8(hg::trd(vp), hg::trd(vp + 4 * TS * 2)), bw, acc[ct], 0, 0, 0); }
        }
        const int t = 16 * w + c; const float bs = F.in[I_SGUB][g4 * 128 + t];
#pragma unroll
        for (int ct = 0; ct < 8; ++ct) { const int col = g4 * 128 + 16 * ct + 4 * g;
            const u32x2 uw = *(const u32x2*)(U + (size_t)(rowbase + t) * SW + col);
            u32x2 o; o.x = pk2(bflo(uw.x) * (acc[ct][0] + bs), bfhi(uw.x) * (acc[ct][1] + bs)); o.y = pk2(bflo(uw.y) * (acc[ct][2] + bs), bfhi(uw.y) * (acc[ct][3] + bs));
            *(u32x2*)(AC + (size_t)(rowbase + t) * D + HW + col) = o; }
    }
    __syncthreads();
}
__device__ __forceinline__ void ph_mix_a(Frame& F) {
    bool did = false;
    for (int it = F.bid; it < 256; it += F.G) if ((it & 7) == 0) { did = true;
        const int seq = it >> 3; SchedCtx S{seq >> 3, (seq >> 1) & 3, seq & 1}; EpiCtx E{F.ws};
        pg8::gemm_phase<EpiCtx, SchedCtx, false>(F.lds, (const bf16_t*)(F.ws + WS_H), D, (const bf16_t*)(F.ws + WS_WIN), D, nullptr, S, E);
    }
    if (did) {
        asm volatile("s_waitcnt vmcnt(0)" ::: "memory"); __syncthreads();
        __builtin_amdgcn_fence(__ATOMIC_ACQUIRE, "agent"); asm volatile("s_waitcnt vmcnt(0)" ::: "memory");
    }
    for (int it = F.bid; it < 256; it += F.G) hg::scan_item<false>(F, it);
    ph_sgu(F);
}
__device__ __forceinline__ void ph_prefix(Frame& F) {
    float* STATE = (float*)(F.ws + WS_STATE); const float* DEC = (const float*)(F.ws + WS_DEC);
    for (int gid = F.bid * NTHR + F.tid; gid < 32 * 4096; gid += F.G * NTHR) {
        const int seq = gid >> 12, q = gid & 4095, t = (q >> 6) & 7, g = (q & 63) >> 4;
        float* st = STATE + (size_t)(seq * 8) * 16384 + 4 * q; const float* dc = DEC + (seq * 8) * 128 + 16 * t + 4 * g;
        f32x4 L[8], Dd[8];
#pragma unroll
        for (int j = 0; j < 8; ++j) { L[j] = *(const f32x4*)(st + (size_t)j * 16384); Dd[j] = *(const f32x4*)(dc + j * 128); }
        f32x4 cacc = L[0];
#pragma unroll
        for (int j = 1; j < 8; ++j) { cacc = Dd[j] * cacc + L[j]; *(f32x4*)(st + (size_t)j * 16384) = cacc; }
    }
}
__device__ __forceinline__ void ph_mix_b(Frame& F) {
    for (int it = F.bid; it < 256; it += F.G) hg::scan_item<true>(F, it);
}

__device__ __forceinline__ void ph_combine(Frame& F) {
    const bf16_t* OD = (const bf16_t*)(F.ws + WS_ODIR); const bf16_t* Gb = (const bf16_t*)(F.ws + WS_G); bf16_t* AC = (bf16_t*)(F.ws + WS_H);
    const int gw = F.vcu * NWAVES + F.wave, NGW = F.G * NWAVES; const int c0 = 8 * F.lane;
    float nw[8];
#pragma unroll
    for (int e = 0; e < 8; ++e) nw[e] = F.in[I_HNW][c0 + e];
    constexpr int U = 8;
    for (int m0 = gw; m0 < ML; m0 += U * NGW) {
        u32x4 a[U], bq[U], gq[U];
#pragma unroll
        for (int u = 0; u < U; ++u) { const int m = m0 + u * NGW; const bool ok = m < ML; const size_t mm = ok ? m : 0;
            a[u] = __builtin_nontemporal_load((const u32x4*)(OD + mm * HW + c0)); bq[u] = __builtin_nontemporal_load((const u32x4*)(OD + (ML + mm) * HW + c0)); gq[u] = __builtin_nontemporal_load((const u32x4*)(Gb + mm * HW + c0)); }
#pragma unroll
        for (int u = 0; u < U; ++u) { const int m = m0 + u * NGW;
            const unsigned aw[4] = {a[u].x, a[u].y, a[u].z, a[u].w}, bw[4] = {bq[u].x, bq[u].y, bq[u].z, bq[u].w}, gw4[4] = {gq[u].x, gq[u].y, gq[u].z, gq[u].w};
            float o[8]; float ss = 0.f;
#pragma unroll
            for (int e = 0; e < 4; ++e) { o[2 * e] = bflo(aw[e]) + bflo(bw[e]); o[2 * e + 1] = bfhi(aw[e]) + bfhi(bw[e]); ss += o[2 * e] * o[2 * e] + o[2 * e + 1] * o[2 * e + 1]; }
            ss += __shfl_xor(ss, 1); ss += __shfl_xor(ss, 2); ss += __shfl_xor(ss, 4); ss += __shfl_xor(ss, 8);
            const float rstd = rsqrtf(ss * (1.f / 128.f) + EPS);
            u32x4 w; unsigned ww[4];
#pragma unroll
            for (int e = 0; e < 4; ++e) ww[e] = pk2(o[2 * e] * rstd * nw[2 * e] * bflo(gw4[e]), o[2 * e + 1] * rstd * nw[2 * e + 1] * bfhi(gw4[e]));
            w.x = ww[0]; w.y = ww[1]; w.z = ww[2]; w.w = ww[3];
            if (m < ML) *(u32x4*)(AC + (size_t)m * D + c0) = w; }
    }
}

__device__ __forceinline__ void ph_norm2(Frame& F) {
    const float* MOD = (const float*)(F.ws + WS_MOD); unsigned char* H2 = F.ws + WS_H; float* AFF = (float*)(F.ws + WS_AFF);
    LAS float* rwl = (LAS float*)F.lds;
    LAS float* cab = (LAS float*)(F.lds + 81920);
    { f32x4 w[8]; const float* rwg = F.in[I_RW];
#pragma unroll
        for (int u = 0; u < 8; ++u) w[u] = *(const f32x4*)(rwg + 4 * (F.tid + NTHR * u));
#pragma unroll
        for (int u = 0; u < 8; ++u) { const int idx = 4 * (F.tid + NTHR * u), k = idx >> 4, n = idx & 15; LAS float* p = rwl + (((k >> 6) * 4 + ((k >> 4) & 3)) * 16 + n) * 20 + (k & 15);
            p[0] = w[u].x; p[20] = w[u].y; p[40] = w[u].z; p[60] = w[u].w; }
        f32x4 nw[2], sc[2], sh[2]; const float* nfg = F.in[I_NFFN];
#pragma unroll
        for (int u = 0; u < 2; ++u) { const int idx = 4 * (F.tid + NTHR * u), b = idx >> 10, col = idx & 1023;
            nw[u] = *(const f32x4*)(nfg + col); sc[u] = *(const f32x4*)(MOD + b * (NMOD * D) + 4 * D + col); sh[u] = *(const f32x4*)(MOD + b * (NMOD * D) + 3 * D + col); }
#pragma unroll
        for (int u = 0; u < 2; ++u) { const int idx = 4 * (F.tid + NTHR * u), b = idx >> 10, col = idx & 1023;
            *(LAS f32x4*)(cab + (b * 2) * D + col) = nw[u] * (sc[u] + 1.f); *(LAS f32x4*)(cab + (b * 2 + 1) * D + col) = sh[u]; } }
    __syncthreads();
    const int gw = F.vcu * NWAVES + F.wave, NGW = F.G * NWAVES;
    const int r = F.lane & 15, q = F.lane >> 4;
    for (int tile = gw; tile < ML / 16; tile += NGW) {
        const int R0 = tile * 16, b = R0 / T;
        const bf16_t* xr = (const bf16_t*)F.out + (size_t)(R0 + r) * (2 * D) + 16 * q;
        u32x4 raw[16][2];
#pragma unroll
        for (int i = 0; i < 16; ++i) { raw[i][0] = *(const u32x4*)(xr + 64 * i); raw[i][1] = *(const u32x4*)(xr + 64 * i + 8); }
        float ss = 0.f;
#pragma unroll
        for (int i = 0; i < 16; ++i)
#pragma unroll
            for (int hq = 0; hq < 2; ++hq) { const unsigned ww[4] = {raw[i][hq].x, raw[i][hq].y, raw[i][hq].z, raw[i][hq].w};
#pragma unroll
                for (int e = 0; e < 4; ++e) { const float x0 = bflo(ww[e]), x1 = bfhi(ww[e]); ss += x0 * x0 + x1 * x1; } }
        ss += __shfl_xor(ss, 16); ss += __shfl_xor(ss, 32);
        const float rstd = rsqrtf(ss * (1.f / D) + EPS);
        const LAS float* cap = cab + (b * 2) * D + 16 * q; const LAS float* rwp = rwl + (q * 16 + r) * 20;
        unsigned char* hp = H2 + (size_t)(R0 + r) * D + 16 * q;
        f32x4 acc = {0.f, 0.f, 0.f, 0.f};
        f32x4 can = *(const LAS f32x4*)cap, cbn = *(const LAS f32x4*)(cap + D), wn = *(const LAS f32x4*)rwp;
        u32x4 o8;
#pragma unroll
        for (int g = 0; g < 64; ++g) {
            const int i = g >> 2, c4 = g & 3;
            const f32x4 ca4 = can, cb4 = cbn, w4 = wn;
            if (g + 1 < 64) { const int i1 = (g + 1) >> 2, c1 = (g + 1) & 3;
                can = *(const LAS f32x4*)(cap + 64 * i1 + 4 * c1); cbn = *(const LAS f32x4*)(cap + D + 64 * i1 + 4 * c1); wn = *(const LAS f32x4*)(rwp + i1 * (4 * 16 * 20) + 4 * c1); }
            unsigned r0 = (c4 & 1) ? raw[i][c4 >> 1].z : raw[i][c4 >> 1].x, r1 = (c4 & 1) ? raw[i][c4 >> 1].w : raw[i][c4 >> 1].y;
            asm volatile("" : "+v"(r0), "+v"(r1));
            const f32x4 x4 = {bflo(r0), bfhi(r0), bflo(r1), bfhi(r1)};
            const f32x4 h4 = x4 * rstd * ca4 + cb4;
            o8[c4] = pk4_f8(h4.x * SC_H8, h4.y * SC_H8, h4.z * SC_H8, h4.w * SC_H8);
            acc = __builtin_amdgcn_mfma_f32_16x16x4f32(h4.x, w4.x, acc, 0, 0, 0); acc = __builtin_amdgcn_mfma_f32_16x16x4f32(h4.y, w4.y, acc, 0, 0, 0);
            acc = __builtin_amdgcn_mfma_f32_16x16x4f32(h4.z, w4.z, acc, 0, 0, 0); acc = __builtin_amdgcn_mfma_f32_16x16x4f32(h4.w, w4.w, acc, 0, 0, 0);
            if (c4 == 3) *(u32x4*)(hp + 64 * i) = o8;
            asm volatile("" ::: "memory");
        }
#pragma unroll
        for (int g = 0; g < 4; ++g) {
            float mx = acc[g];
            mx = fmaxf(mx, __shfl_xor(mx, 1)); mx = fmaxf(mx, __shfl_xor(mx, 2)); mx = fmaxf(mx, __shfl_xor(mx, 4)); mx = fmaxf(mx, __shfl_xor(mx, 8));
            const float ex = __expf(acc[g] - mx);
            float den = ex; den += __shfl_xor(den, 1); den += __shfl_xor(den, 2); den += __shfl_xor(den, 4); den += __shfl_xor(den, 8);
            AFF[(size_t)(R0 + 4 * q + g) * NE + r] = ex / den;
        }
    }
}

__device__ __forceinline__ void ph_topk(Frame& F) {
    LAS unsigned* cnt = (LAS unsigned*)F.lds;
    const float* AFF = (const float*)(F.ws + WS_AFF); int* SLOT = (int*)(F.ws + WS_SLOT); int* ROWMAP = (int*)(F.ws + WS_ROWMAP); float* GATE = (float*)(F.ws + WS_GATE);
    for (int item = F.bid; item < NB * NE; item += F.G) {
        const int b = item >> 4, e = item & 15;
        unsigned key[16];
#pragma unroll
        for (int j = 0; j < 16; ++j) key[j] = __builtin_bit_cast(unsigned, AFF[(size_t)(b * T + F.tid * 16 + j) * NE + e]);
        unsigned thr = 0u;
#pragma unroll 1
        for (int bit = 31; bit >= 0; --bit) {
            const unsigned cand = thr | (1u << bit); unsigned c = 0u;
#pragma unroll
            for (int j = 0; j < 16; ++j) c += (key[j] >= cand) ? 1u : 0u;
#pragma unroll
            for (int o = 1; o < 64; o <<= 1) c += __shfl_xor(c, o);
            LAS unsigned* slot = cnt + (bit & 1) * 8;
            if (F.lane == 0) slot[F.wave] = c;
            __syncthreads();
            unsigned tot = 0u;
#pragma unroll
            for (int w = 0; w < 8; ++w) tot += slot[w];
            if (tot >= (unsigned)CAP) thr = cand;
        }
        unsigned cg = 0u, ce = 0u;
#pragma unroll
        for (int j = 0; j < 16; ++j) { cg += (key[j] > thr) ? 1u : 0u; ce += (key[j] == thr) ? 1u : 0u; }
        unsigned ig = cg, ie = ce;
#pragma unroll
        for (int o = 1; o < 64; o <<= 1) { const unsigned tg = __shfl_up(ig, o), te = __shfl_up(ie, o); if (F.lane >= o) { ig += tg; ie += te; } }
        if (F.lane == 63) { cnt[32 + F.wave] = ig; cnt[40 + F.wave] = ie; }
        __syncthreads();
        unsigned pg = ig - cg, pe = ie - ce, total_gt = 0u;
        for (int w = 0; w < 8; ++w) { const unsigned wg = cnt[32 + w]; total_gt += wg; if (w < F.wave) { pg += wg; pe += cnt[40 + w]; } }
        const unsigned want_eq = CAP - total_gt;
#pragma unroll
        for (int j = 0; j < 16; ++j) { const int i = F.tid * 16 + j; const unsigned k = key[j]; int slot = -1;
            if (k > thr) slot = (int)(pg++);
            else if (k == thr) { const unsigned r = pe++; if (r < want_eq) slot = (int)(total_gt + r); }
            SLOT[(size_t)(b * T + i) * NE + e] = slot;
            if (slot >= 0) { ROWMAP[item * CAP + slot] = b * T + i; GATE[item * CAP + slot] = __builtin_bit_cast(float, k); } }
        __syncthreads();
    }
}

__device__ __forceinline__ void ph_final(Frame& F) {
    const float* MOD = (const float*)(F.ws + WS_MOD); const unsigned char* YE = F.ws + WS_YE; const int* SLOT = (const int*)(F.ws + WS_SLOT);
    const int gw = F.vcu * NWAVES + F.wave, NGW = F.G * NWAVES;
    f32x4 fw[4];
#pragma unroll
    for (int j = 0; j < 4; ++j) fw[j] = *(const f32x4*)(F.in[I_FNW] + 4 * F.lane + 256 * j);
    for (int m = gw; m < ML; m += NGW) {
        const int b = m / T;
        float* xr = F.out + (size_t)m * D;
        f32x4 v[4], mo[4];
#pragma unroll
        for (int j = 0; j < 4; ++j) { const u32x2 w = *(const u32x2*)((const bf16_t*)xr + 4 * F.lane + 256 * j); v[j] = (f32x4){bflo(w.x), bfhi(w.x), bflo(w.y), bfhi(w.y)}; mo[j] = (f32x4){0.f, 0.f, 0.f, 0.f}; }
        const int sl = (F.lane < NE) ? SLOT[(size_t)m * NE + F.lane] : -1;
        for (int e = 0; e < NE; ++e) { const int s = __shfl(sl, e);
            if (s >= 0) { const unsigned char* yr = YE + ((size_t)(b * NE + e) * CAP + s) * D;
#pragma unroll
                for (int j = 0; j < 4; ++j) mo[j] += f8x4_f32(*(const unsigned*)(yr + 4 * F.lane + 256 * j)); } }
        float ss = 0.f;
#pragma unroll
        for (int j = 0; j < 4; ++j) { const f32x4 gf = *(const f32x4*)(MOD + b * (NMOD * D) + 5 * D + 4 * F.lane + 256 * j) * (1.f / SC_YE8); v[j] += gf * mo[j]; ss += (v[j].x * v[j].x + v[j].y * v[j].y) + (v[j].z * v[j].z + v[j].w * v[j].w); }
        const float rstd = rsqrtf(wave_sum(ss) * (1.f / D) + EPS);
#pragma unroll
        for (int j = 0; j < 4; ++j) *(f32x4*)(xr + 4 * F.lane + 256 * j) = v[j] * rstd * fw[j];
    }
}

constexpr int N_PHASES = 14;
#ifndef SCHED_GR
#define SCHED_GR 4
#endif
__global__ void __launch_bounds__(NTHR, 2) skel_fwd(Args args) {
    extern __shared__ __attribute__((aligned(16))) unsigned char lds_raw[];
    Frame F;
    F.lds = (LAS unsigned char*)lds_raw;
    F.tid = threadIdx.x; F.lane = F.tid & 63; F.wave = __builtin_amdgcn_readfirstlane(F.tid >> 6);
    F.G = gridDim.x; F.bid = blockIdx.x; F.vcu = (F.G % 8 == 0) ? (F.bid % 8) * (F.G / 8) + F.bid / 8 : F.bid;
    F.out = args.out; F.ws = args.ws;
    volatile LAS unsigned* MISC = (volatile LAS unsigned*)(F.lds + MISC_OFF);
    for (int u = F.tid; u < (LDS_BYTES - LDSCTL_OFF) / 4; u += NTHR) ((LAS unsigned*)(F.lds + LDSCTL_OFF))[u] = 0u;
    __syncthreads();
    XcdBarrier bar; bar.bar = (unsigned*)(F.ws + WS_CTL) + CW_BAR; bar.x = 0; bar.st = nullptr;
#if !MK_PER_PHASE
    bar = xcd_barrier_post((unsigned*)(F.ws + WS_CTL) + CW_BAR, MISC + 8);
#endif
    const int lo = args.ph_lo, hi = args.ph_hi;
#ifndef PH_MASK
#define PH_MASK 0x3fff
#endif
#define IN(k) (((PH_MASK >> (k)) & 1) && lo <= (k) && (k) < hi)
#define SEAM(k) do { if (IN(k) && IN((k) + 1)) xcd_barrier(bar); } while (0)
    if (IN(0)) { ph_prologue(F); } SEAM(0);
    if (IN(1)) { ph_norm1(F); } SEAM(1);
    if (IN(2)) { { SchedIn S; S.init(F.G, F.bid, 14); EpiIn E{F.ws};
            pg8::gemm_phase<EpiIn, SchedIn, false>(F.lds, (const bf16_t*)(F.ws + WS_H), D, (const bf16_t*)(F.ws + WS_WIN), D, nullptr, S, E); }
        { SchedGab S; S.s.init(F.G, F.bid, 8); EpiGab E{F.ws};
            pg8::gemm_phase<EpiGab, SchedGab, false, pg8::NoHook, true>(F.lds, (const bf16_t*)(F.ws + WS_H8), D / 2, (const bf16_t*)(F.ws + WS_W8), D / 2, nullptr, S, E); } } SEAM(2);
    if (IN(3)) { ph_mix_a(F); } SEAM(3);
    if (IN(4)) { ph_prefix(F); } SEAM(4);
    if (IN(5)) { ph_mix_b(F); } SEAM(5);
    if (IN(6)) { ph_combine(F); } SEAM(6);
    if (IN(7)) { StaticOrder S; S.init(128, 4, F.G, F.bid); EpiGate<false> E{(const bf16_t*)(F.ws + WS_GB), nullptr, (bf16_t*)(F.ws + WS_MERGED)}; HookRatio HK{(const bf16_t*)(F.ws + WS_GA)};
        pg8::gemm_phase<EpiGate<false>, StaticOrder, false, HookRatio>(F.lds, (const bf16_t*)(F.ws + WS_H), D, (const bf16_t*)(F.ws + WS_WA), D, nullptr, S, E, HK); } SEAM(7);
    if (IN(8)) { StaticOrder S; S.init(128, 4, F.G, F.bid); EpiX1 E{F.in[I_X], (const float*)(F.ws + WS_MOD), (bf16_t*)F.out};
        pg8::gemm_phase<EpiX1, StaticOrder, false>(F.lds, (const bf16_t*)(F.ws + WS_MERGED), D, (const bf16_t*)(F.ws + WS_WO), D, nullptr, S, E); } SEAM(8);
    if (IN(9)) { ph_norm2(F); } SEAM(9);
    if (IN(10)) { ph_topk(F); econv_queue(F); } SEAM(10);
    if (IN(11)) { SchedMoe1 S{F.G, F.vcu}; EpiHid E{F.ws + WS_HID};
        pg8::gemm_phase<EpiHid, SchedMoe1, true, pg8::NoHook, true>(F.lds, (const bf16_t*)(F.ws + WS_H), D / 2, (const bf16_t*)(F.ws + WS_WGU), D / 2, (const int*)(F.ws + WS_ROWMAP), S, E); } SEAM(11);
    if (IN(12)) { SchedMoe2 S{F.G, F.vcu}; EpiYe E{(const float*)(F.ws + WS_GATE), F.ws + WS_YE};
        pg8::gemm_phase<EpiYe, SchedMoe2, false, pg8::NoHook, true>(F.lds, (const bf16_t*)(F.ws + WS_HID), FF / 2, (const bf16_t*)(F.ws + WS_WD), FF / 2, nullptr, S, E); } SEAM(12);
    if (IN(13)) { ph_final(F); }
#undef IN
#undef SEAM
}

extern "C" void kernel_launch(void* const* d_in, const int* in_sizes, int n_in, void* d_out, int out_size, void* d_ws, size_t ws_size, hipStream_t stream) {
    static int grid = 0;
    if (grid == 0) {
        if (n_in != N_IN || in_sizes[0] != ML * D || out_size != ML * D || ws_size < WS_END) { fprintf(stderr, "kernel_launch: unexpected shapes (n_in %d, in0 %d, out %d, ws %zu < %zu); nothing launched\n", n_in, n_in > 0 ? in_sizes[0] : -1, out_size, ws_size, (size_t)WS_END); grid = -1; return; }
        int dev = 0, cus = 0, per_cu = 0;
        if (hipGetDevice(&dev) != hipSuccess || hipDeviceGetAttribute(&cus, hipDeviceAttributeMultiprocessorCount, dev) != hipSuccess) { grid = -1; return; }
        if (hipFuncSetAttribute((const void*)skel_fwd, hipFuncAttributeMaxDynamicSharedMemorySize, LDS_BYTES) != hipSuccess) { fprintf(stderr, "kernel_launch: hipFuncSetAttribute failed\n"); grid = -1; return; }
        if (hipOccupancyMaxActiveBlocksPerMultiprocessor(&per_cu, (const void*)skel_fwd, NTHR, LDS_BYTES) != hipSuccess || per_cu < 1) fprintf(stderr, "kernel_launch: occupancy query says %d\n", per_cu);
        (void)hipGetLastError();
        grid = cus;
    }
    if (grid < 0) return;
    if (hipMemsetAsync((char*)d_ws + WS_CTL, 0, CTL_ZERO_BYTES, stream) != hipSuccess) return;
    Args a{};
    for (int i = 0; i < N_IN; ++i) a.in[i] = (const float*)d_in[i];
    a.out = (float*)d_out; a.ws = (unsigned char*)d_ws;
#if MK_PER_PHASE
#ifndef DBG_NPH
#define DBG_NPH N_PHASES
#endif
    for (int p = 0; p < DBG_NPH; ++p) { a.ph_lo = p; a.ph_hi = p + 1; hipLaunchKernelGGL(skel_fwd, dim3(grid), dim3(NTHR), LDS_BYTES, stream, a); }
#else
    a.ph_lo = 0; a.ph_hi = N_PHASES; hipLaunchKernelGGL(skel_fwd, dim3(grid), dim3(NTHR), LDS_BYTES, stream, a);
#endif
}
```

```cpp
#include <hip/hip_runtime.h>
#include <cstdio>
#include <cstdint>

#ifndef SCHED_GR
#define SCHED_GR 2
#endif
#ifndef MK_PER_PHASE
#define MK_PER_PHASE 0
#endif

#define GAS __attribute__((address_space(1)))
#define LAS __attribute__((address_space(3)))
typedef unsigned short bf16_t;
typedef short bf16x8 __attribute__((ext_vector_type(8)));
typedef float f32x4 __attribute__((ext_vector_type(4)));
typedef float f32x2 __attribute__((ext_vector_type(2)));
typedef unsigned u32x4 __attribute__((ext_vector_type(4)));
typedef unsigned u32x2 __attribute__((ext_vector_type(2)));
typedef GAS unsigned gu32;

constexpr int D = 1024, NB = 4, T = 8192, ML = NB * T  , CTXL = 256, MC = NB * CTXL  , MT = ML + MC  ;
constexpr int NH = 4, DK = 128, HW = 512, SW = 512, NE = 16, FF = 2048, CAP = 1024, NMOD = 6, INC = 5632;
constexpr float EPS = 1e-6f;
constexpr int NWAVES = 8, NTHR = 512;

constexpr size_t MiB = 1u << 20;
constexpr size_t WS_CTL = 0, CTL_ZERO_BYTES = 1 * MiB;
constexpr size_t WS_MOD = 1 * MiB;
constexpr size_t WS_LB = 1 * MiB + 256 * 1024;
constexpr size_t WS_WIN = 2 * MiB;
constexpr size_t WS_WA = 13 * MiB, WS_WB = 14 * MiB, WS_WO = 15 * MiB;
constexpr size_t WS_AFF = 17 * MiB;
constexpr size_t WS_ROWMAP = 19 * MiB;
constexpr size_t WS_GATE = 19 * MiB + 512 * 1024;
constexpr size_t WS_SLOT = 20 * MiB;
constexpr size_t WS_STATE = 22 * MiB;
constexpr size_t WS_DEC = 40 * MiB;
constexpr size_t WS_H = 48 * MiB;
constexpr size_t WS_Q = 114 * MiB, WS_FF = 147 * MiB, WS_FB = 180 * MiB, WS_V = 213 * MiB;
constexpr size_t WS_G = 246 * MiB, WS_U = 278 * MiB, WS_VS = 310 * MiB;
constexpr size_t WS_GA = 342 * MiB, WS_GB = 406 * MiB;
constexpr size_t WS_ODIR = 278 * MiB;
constexpr size_t WS_T = 180 * MiB;
constexpr size_t WS_MERGED = 114 * MiB;
constexpr size_t WS_WGU = 114 * MiB;
constexpr size_t WS_YE = 114 * MiB;
constexpr size_t WS_WD = 498 * MiB;
constexpr size_t WS_HID = 242 * MiB;
constexpr size_t WS_H8 = 530 * MiB;
constexpr size_t WS_W8 = WS_WIN + (size_t)3584 * 2048;
constexpr size_t WS_END = 562 * MiB;

constexpr int CW_BAR = 4096, CW_QUEUE = 8192, CW_QUEUE2 = 8192 + 64;

constexpr int RING_BYTES = 131072;
constexpr int CONV_OFF = 118784;
constexpr int LDSCTL_OFF = 155648, MISC_OFF = LDSCTL_OFF + 320, RM_OFF = LDSCTL_OFF + 2048;
constexpr int LDS_BYTES = 159744;

#define RLX_AGENT __ATOMIC_RELAXED, __HIP_MEMORY_SCOPE_AGENT
#define LDS_WAIT() asm volatile("s_waitcnt lgkmcnt(0)" ::: "memory")
#define VM_WAIT() asm volatile("s_waitcnt vmcnt(0)" ::: "memory")
__device__ __forceinline__ unsigned f2bf(float f) { unsigned u = __builtin_bit_cast(unsigned, f); return (u + 0x7fffu + ((u >> 16) & 1u)) >> 16; }
__device__ __forceinline__ unsigned pk2(float lo, float hi) { return f2bf(lo) | (f2bf(hi) << 16); }
__device__ __forceinline__ float bf2f(unsigned short h) { return __builtin_bit_cast(float, (unsigned)h << 16); }
__device__ __forceinline__ float bflo(unsigned w) { return __builtin_bit_cast(float, w << 16); }
__device__ __forceinline__ float bfhi(unsigned w) { return __builtin_bit_cast(float, w & 0xffff0000u); }
typedef __bf16 bf16x2_t __attribute__((ext_vector_type(2)));
__device__ __forceinline__ unsigned cvt_pk_bf16(float lo, float hi) { f32x2 v = {lo, hi}; bf16x2_t b = __builtin_convertvector(v, bf16x2_t); return __builtin_bit_cast(unsigned, b); }
__device__ __forceinline__ float clamp448(float v) { return copysignf(fminf(fabsf(v), 448.f), v); }
__device__ __forceinline__ unsigned pk4_f8(float a, float b, float c, float d) {
    const float a1 = clamp448(a);
    const int w = __builtin_amdgcn_cvt_pk_fp8_f32(a1, clamp448(b), __builtin_bit_cast(int, a1), false);
    return (unsigned)__builtin_amdgcn_cvt_pk_fp8_f32(clamp448(c), clamp448(d), w, true);
}
constexpr float SC_W8 = 1024.f, SC_H8 = 16.f, SC_HID8 = 8.f, SC_YE8 = 64.f;
__device__ __forceinline__ f32x4 f8x4_f32(unsigned w) { const f32x2 lo = __builtin_amdgcn_cvt_pk_f32_fp8((int)w, false), hi = __builtin_amdgcn_cvt_pk_f32_fp8((int)w, true); return (f32x4){lo[0], lo[1], hi[0], hi[1]}; }
__device__ __forceinline__ float sigm(float x) { return __builtin_amdgcn_rcpf(1.f + __expf(-x)); }
__device__ __forceinline__ float siluf(float x) { return x * sigm(x); }
__device__ __forceinline__ float geluf(float x) { return x * sigm(1.5957691216057308f * (x + 0.044715f * x * x * x)); }
__device__ __forceinline__ float wave_sum(float v) {
#pragma unroll
    for (int o = 1; o < 64; o <<= 1) v += __shfl_xor(v, o);
    return v;
}

#define XB_TMO      128
#define XB_XCNT(j)  (256  + 64 * (j))
#define XB_XSUB(j)  (1280 + 64 * (j))
#define XB_XGEN(j)  (2304 + 64 * (j))
#define XB_TOP      3328
#define XB_TOPGEN   3392
#define XCD_BAR_WORDS 3456
#define XB_SPIN_CAP (1u << 20)
__device__ __forceinline__ unsigned xb_ld(unsigned* p)              { return __hip_atomic_load(p, __ATOMIC_RELAXED, __HIP_MEMORY_SCOPE_AGENT); }
__device__ __forceinline__ unsigned xb_add(unsigned* p, unsigned v) { return __hip_atomic_fetch_add(p, v, __ATOMIC_RELAXED, __HIP_MEMORY_SCOPE_AGENT); }
__device__ __forceinline__ unsigned xb_xcc_id() { return (unsigned)__builtin_amdgcn_s_getreg((3 << 11) | 20) & 0xFu; }
#define XB_SPIN(cond, bar) do { unsigned _sp = 0; while (cond) { __builtin_amdgcn_s_sleep(1); \
    if ((++_sp & 255u) == 0u) { if (xb_ld(&(bar)[XB_TMO])) break; if (_sp > XB_SPIN_CAP) { atomicAdd(&(bar)[XB_TMO], 1u); break; } } } } while (0)
struct XcdBarrier { unsigned* bar; unsigned x; volatile LAS unsigned* st; };
__device__ __forceinline__ XcdBarrier xcd_barrier_post(unsigned* bar, volatile LAS unsigned* st) {
    XcdBarrier b; b.bar = bar; b.x = xb_xcc_id(); b.st = st;
    if (threadIdx.x == 0) (void)xb_add(&bar[XB_XCNT(b.x)], 1u);
    return b;
}
__device__ __forceinline__ void xcd_barrier_complete(unsigned* bar, unsigned x, unsigned& nloc, unsigned& nx) {
    const unsigned G = gridDim.x * gridDim.y * gridDim.z;
    unsigned sum, cnt, mine, sp = 0u;
    for (;;) {
        sum = 0u; cnt = 0u; mine = 0u;
#pragma unroll
        for (unsigned j = 0; j < 16; ++j) { const unsigned c = xb_ld(&bar[XB_XCNT(j)]); sum += c; cnt += (c > 0u) ? 1u : 0u; mine = (j == x) ? c : mine; }
        if (sum == G) break;
        __builtin_amdgcn_s_sleep(1);
        if ((++sp & 255u) == 0u) { if (xb_ld(&bar[XB_TMO])) break; if (sp > XB_SPIN_CAP) { atomicAdd(&bar[XB_TMO], 1u); break; } }
    }
    nloc = mine > 0u ? mine : 1u; nx = cnt > 0u ? cnt : 1u;
}
__device__ __forceinline__ void xcd_barrier(const XcdBarrier& b) {
    asm volatile("s_waitcnt vmcnt(0)" ::: "memory");
    __syncthreads();
    if (threadIdx.x == 0) {
        unsigned* bar = b.bar;
        __builtin_amdgcn_s_waitcnt(0);
        unsigned nloc = b.st[0], nx = b.st[1];
        if (nloc == 0u) { xcd_barrier_complete(bar, b.x, nloc, nx); b.st[0] = nloc; b.st[1] = nx; }
        const unsigned old = xb_add(&bar[XB_XSUB(b.x)], 1u);
        const unsigned gen = old / nloc;
        if (old + 1u == (gen + 1u) * nloc) {
            __builtin_amdgcn_fence(__ATOMIC_RELEASE, "agent");
            asm volatile("s_waitcnt vmcnt(0)" ::: "memory");
            const unsigned og = xb_add(&bar[XB_TOP], 1u);
            const unsigned tg = og / nx;
            if (og + 1u == (tg + 1u) * nx) xb_add(&bar[XB_TOPGEN], 1u);
            else XB_SPIN(xb_ld(&bar[XB_TOPGEN]) == tg, bar);
            __builtin_amdgcn_fence(__ATOMIC_ACQUIRE, "agent");
            xb_add(&bar[XB_XGEN(b.x)], 1u);
            asm volatile("s_waitcnt vmcnt(0)" ::: "memory");
        } else {
            XB_SPIN(xb_ld(&bar[XB_XGEN(b.x)]) == gen, bar);
            __builtin_amdgcn_fence(__ATOMIC_ACQUIRE, "agent");
            asm volatile("s_waitcnt vmcnt(0)" ::: "memory");
        }
    }
    __syncthreads();
}

namespace pg8 {
constexpr int BM = 256, BK = 64, HALF = 128, HTB = HALF * BK * 2, STAGE_BYTES = 8 * HTB;
__host__ __device__ __forceinline__ int lds_byte(int r, int c) { const int st = (r >> 4) * 2 + (c >> 5), rr = r & 15, cc = c & 31, ob = rr * 64 + cc * 2; return st * 1024 + (ob ^ (((ob >> 9) & 1) << 5)); }
__host__ __device__ __forceinline__ void stage_rc(int b, int& R, int& C) { const int st = b / 1024, sb = b % 1024, swz = sb ^ (((sb >> 9) & 1) << 5); R = (st >> 1) * 16 + swz / 64; C = (st & 1) * 32 + (swz % 64) / 2; }
__host__ __device__ __forceinline__ int perm32(int rho) { const int n = rho >> 4, i = rho & 15; return 8 * (i >> 2) + 4 * n + (i & 3); }
struct Unit { int pm, pn, b0, b1; };
__device__ __forceinline__ void std_halves(Unit& u) { u.b0 = u.pn * 256; u.b1 = u.pn * 256 + 128; }

__device__ __forceinline__ const char* sptr(const char* p) { const unsigned long long v = (unsigned long long)p;
    const unsigned lo = (unsigned)__builtin_amdgcn_readfirstlane((int)(unsigned)v), hi = (unsigned)__builtin_amdgcn_readfirstlane((int)(unsigned)(v >> 32));
    return (const char*)(((unsigned long long)hi << 32) | lo); }
struct NoHook { static constexpr bool ON = false; __device__ __forceinline__ void operator()(f32x4 (&)[2][2][4][2], const Unit&, int, int, int, int) const {} };
typedef int i32x8 __attribute__((ext_vector_type(8)));
typedef int i32x4 __attribute__((ext_vector_type(4)));
__device__ __forceinline__ void mma8(f32x4& c, const bf16x8& a0, const bf16x8& a1, const bf16x8& b0, const bf16x8& b1) {
    const i32x4 x0 = __builtin_bit_cast(i32x4, a0), x1 = __builtin_bit_cast(i32x4, a1), y0 = __builtin_bit_cast(i32x4, b0), y1 = __builtin_bit_cast(i32x4, b1);
    const i32x8 X = {x0[0], x0[1], x0[2], x0[3], x1[0], x1[1], x1[2], x1[3]}, Y = {y0[0], y0[1], y0[2], y0[3], y1[0], y1[1], y1[2], y1[3]};
    asm volatile("v_mfma_f32_16x16x128_f8f6f4 %0, %1, %2, %0" : "+v"(c) : "v"(X), "v"(Y));
}
template <class Epi, class Sched, bool GATHER, class Hook = NoHook, bool F8 = false>
__device__ __forceinline__ void gemm_phase(LAS unsigned char* lds, const bf16_t* A, const int lda, const bf16_t* Bt, const int K, const int* rowmap, const Sched& S, const Epi& E, const Hook& HK = Hook()) {
    int tid_ = threadIdx.x; asm volatile("" : "+v"(tid_));
    const int tid = tid_, wid = __builtin_amdgcn_readfirstlane(tid >> 6), lane = tid & 63, wr = wid >> 2, wc = wid & 3, fr = lane & 15, fq = lane >> 4;
    const int nt = K / BK;
    const unsigned rowB = (unsigned)lda * 2u;
    unsigned CA2, voffB, voffA; int vRM;
    { int R, C; stage_rc(tid * 16, R, C); const int Rb = Epi::PERM ? ((R & ~31) + perm32(R & 31)) : R;
        CA2 = (unsigned)C * 2u; voffB = (unsigned)(Rb * K + C) * 2u; voffA = (unsigned)R * rowB + (unsigned)C * 2u; vRM = RM_OFF + R * 4; }
    const size_t kstep = (size_t)(BK * 2);
    const size_t rowK = (size_t)K * 2;
    const size_t halfA = (size_t)HALF * rowB, d64A = (size_t)64 * rowB, d64B = (size_t)64 * rowK;
    const unsigned ldsw = (unsigned)wid * 1024u;
    const int aoff = lds_byte(wr * 64 + fr, fq * 8), boff = lds_byte(wc * 32 + fr, fq * 8);
#define PG8_SA(b, h) (((b) * 2 + (h)) * HTB)
#define PG8_SB(b, h) ((4 + (b) * 2 + (h)) * HTB)
#define PG8_DMA(bufoff, i, ptr) __builtin_amdgcn_global_load_lds((const unsigned*)(ptr), (LAS unsigned*)(lds + (bufoff) + ldsw + (i) * 8192), 16, 0, 0)
#define PG8_STAGE(bufoff, gbase, voff, delta) do { const char* _g0 = sptr((const char*)(gbase)); const char* _g1 = sptr((const char*)(gbase) + (delta)); \
        unsigned _o = (voff); asm volatile("" : "+v"(_o)); PG8_DMA(bufoff, 0, _g0 + _o); PG8_DMA(bufoff, 1, _g1 + _o); } while (0)
#define PG8_STAGE_G(bufoff, gbase, offs) do { const char* _g = sptr((const char*)(gbase)); _Pragma("unroll") for (int _i = 0; _i < 2; ++_i) { \
        unsigned _o = (offs)[_i]; asm volatile("" : "+v"(_o)); PG8_DMA(bufoff, _i, _g + _o); } } while (0)
#define PG8_STAGE_B(bufoff, gbase) PG8_STAGE(bufoff, gbase, voffB, d64B)
#define PG8_RMGET(dst, h, nu) do { if constexpr (GATHER) { const int _ro = ((nu) ? (rmbuf ^ 1) : rmbuf) * 1024 + (h) * 512; \
        _Pragma("unroll") for (int _i = 0; _i < 2; ++_i) dst[_i] = *(const LAS unsigned*)(lds + vRM + _ro + _i * 256) * rowB + CA2; } } while (0)
#define PG8_STAGE_A(bufoff, kb, h, nu, offs) do { if constexpr (GATHER) PG8_STAGE_G(bufoff, (const char*)A + (kb), offs); \
        else PG8_STAGE(bufoff, ((nu) ? nAu : cAu) + (size_t)(h) * halfA + (kb), voffA, d64A); } while (0)
#define PG8_LDA(dst, b, h) do { _Pragma("unroll") for (int m = 0; m < 4; ++m) _Pragma("unroll") for (int k = 0; k < 2; ++k) dst[m][k] = *(const LAS bf16x8*)(lds + PG8_SA(b, h) + aoff + m * 2048 + k * 1024); } while (0)
#define PG8_LDB(dst, b, h) do { _Pragma("unroll") for (int n = 0; n < 2; ++n) _Pragma("unroll") for (int k = 0; k < 2; ++k) dst[n][k] = *(const LAS bf16x8*)(lds + PG8_SB(b, h) + boff + n * 2048 + k * 1024); } while (0)
#define PG8_MMA(ai, bj, At, Bt_) do { __builtin_amdgcn_s_setprio(1); _Pragma("unroll") for (int m = 0; m < 4; ++m) _Pragma("unroll") for (int n = 0; n < 2; ++n) { \
        if constexpr (F8) mma8(acc[ai][bj][m][n], Bt_[n][0], Bt_[n][1], At[m][0], At[m][1]); \
        else { _Pragma("unroll") for (int k = 0; k < 2; ++k) acc[ai][bj][m][n] = __builtin_amdgcn_mfma_f32_16x16x32_bf16(Bt_[n][k], At[m][k], acc[ai][bj][m][n], 0, 0, 0); } } \
        __builtin_amdgcn_s_setprio(0); } while (0)
#define PG8_WAIT_V(n) asm volatile("s_waitcnt vmcnt(" #n ")" ::: "memory")
#define PG8_WAIT_L(n) asm volatile("s_waitcnt lgkmcnt(" #n ")" ::: "memory")
#define PG8_BAR __builtin_amdgcn_s_barrier()
#define PG8_SCHED __builtin_amdgcn_sched_barrier(0)
    Unit cur, nxt; int ui = 0;
    if (!S.next(0, cur)) return;
    int rmbuf = 0;
    if constexpr (GATHER) {
        if (wid < 4) { unsigned _o = (unsigned)tid * 4u; asm volatile("" : "+v"(_o)); __builtin_amdgcn_global_load_lds((const unsigned*)(sptr((const char*)(rowmap + cur.pm * BM)) + _o), (LAS unsigned*)(lds + RM_OFF + wid * 256), 4, 0, 0); }
        PG8_WAIT_V(0); __syncthreads();
    }
    f32x4 acc[2][2][4][2];
#pragma unroll
    for (int a = 0; a < 2; ++a)
#pragma unroll
        for (int b = 0; b < 2; ++b)
#pragma unroll
            for (int m = 0; m < 4; ++m)
#pragma unroll
                for (int n = 0; n < 2; ++n) acc[a][b][m][n] = (f32x4){0.f, 0.f, 0.f, 0.f};
    bf16x8 At[4][2], B0[2][2], B1[2][2];
    const char* cAu = (const char*)A + (GATHER ? (size_t)0 : (size_t)(cur.pm * BM) * rowB); const char* nAu = cAu;
    const char* cB0 = (const char*)Bt + (size_t)cur.b0 * rowK; const char* cB1 = (const char*)Bt + (size_t)cur.b1 * rowK;
    unsigned ro[2] = {0u, 0u}, ro1[2] = {0u, 0u};
    PG8_RMGET(ro, 0, false); PG8_RMGET(ro1, 1, false);
    PG8_STAGE_B(PG8_SB(0, 0), cB0); PG8_STAGE_B(PG8_SB(0, 1), cB1); PG8_STAGE_A(PG8_SA(0, 0), (size_t)0, 0, false, ro); PG8_STAGE_A(PG8_SA(0, 1), (size_t)0, 1, false, ro1);
    if (wr == 1) PG8_BAR;
    PG8_WAIT_V(2); PG8_BAR;
    PG8_STAGE_B(PG8_SB(1, 0), cB0 + kstep); PG8_STAGE_A(PG8_SA(1, 0), kstep, 0, false, ro); PG8_STAGE_B(PG8_SB(1, 1), cB1 + kstep);
    PG8_WAIT_V(6); PG8_BAR;
    for (;;) {
        const bool has_next = S.next(ui + 1, nxt);
        const char* nB0 = has_next ? (const char*)Bt + (size_t)nxt.b0 * rowK : cB0; const char* nB1 = has_next ? (const char*)Bt + (size_t)nxt.b1 * rowK : cB1;
        if constexpr (GATHER) {
            if (has_next && wid < 4) { unsigned _o = (unsigned)tid * 4u; asm volatile("" : "+v"(_o)); __builtin_amdgcn_global_load_lds((const unsigned*)(sptr((const char*)(rowmap + nxt.pm * BM)) + _o), (LAS unsigned*)(lds + RM_OFF + (rmbuf ^ 1) * 1024 + wid * 256), 4, 0, 0); }
        } else nAu = has_next ? (const char*)A + (size_t)(nxt.pm * BM) * rowB : cAu;
#pragma unroll 1
        for (int t = 0; t < nt; t += 2) {
            const bool last = (t == nt - 2), nu = last && has_next;
            if constexpr (Hook::ON) { if (t == nt / 2) HK(acc, cur, wr, wc, fr, fq); }
            const size_t k1 = (size_t)(t + 1) * kstep, k2 = last ? (size_t)0 : (size_t)(t + 2) * kstep, k3 = k2 + kstep;
            const char* b20 = last ? nB0 : cB0 + k2; const char* b21 = last ? nB1 : cB1 + k2;
            const char* b30 = b20 + kstep; const char* b31 = b21 + kstep;
            PG8_RMGET(ro, 1, false); PG8_LDB(B0, 0, 0); PG8_LDB(B1, 0, 1); PG8_SCHED; PG8_LDA(At, 0, 0); PG8_STAGE_A(PG8_SA(1, 1), k1, 1, false, ro);
            PG8_WAIT_V(8); PG8_WAIT_L(0); PG8_BAR; PG8_MMA(0, 0, At, B0); PG8_MMA(0, 1, At, B1); PG8_BAR; PG8_SCHED;
            PG8_RMGET(ro, 0, nu); PG8_LDA(At, 0, 1); PG8_STAGE_B(PG8_SB(0, 0), b20); PG8_STAGE_B(PG8_SB(0, 1), b21); PG8_STAGE_A(PG8_SA(0, 0), k2, 0, last, ro);
            PG8_WAIT_V(8); PG8_WAIT_L(0); PG8_BAR; PG8_MMA(1, 0, At, B0); PG8_MMA(1, 1, At, B1); PG8_BAR; PG8_SCHED;
            PG8_RMGET(ro, 1, nu); PG8_LDB(B0, 1, 0); PG8_LDB(B1, 1, 1); PG8_SCHED; PG8_LDA(At, 1, 0); PG8_STAGE_A(PG8_SA(0, 1), k2, 1, last, ro);
            PG8_WAIT_V(8); PG8_WAIT_L(0); PG8_BAR; PG8_MMA(0, 0, At, B0); PG8_MMA(0, 1, At, B1); PG8_BAR; PG8_SCHED;
            PG8_RMGET(ro, 0, nu); PG8_LDA(At, 1, 1); PG8_STAGE_B(PG8_SB(1, 0), b30); PG8_STAGE_B(PG8_SB(1, 1), b31); PG8_STAGE_A(PG8_SA(1, 0), k3, 0, last, ro);
            PG8_WAIT_V(8); PG8_WAIT_L(0); PG8_BAR; PG8_MMA(1, 0, At, B0); PG8_MMA(1, 1, At, B1); PG8_BAR; PG8_SCHED;
        }
        if (wr == 0) PG8_BAR;
        if constexpr (F8) asm volatile("s_nop 7\n\ts_nop 7\n\ts_nop 7" ::: "memory");
        E(acc, cur, wr, wc, fr, fq);
        if (!has_next) break;
#pragma unroll
        for (int a = 0; a < 2; ++a)
#pragma unroll
            for (int b = 0; b < 2; ++b)
#pragma unroll
                for (int m = 0; m < 4; ++m)
#pragma unroll
                    for (int n = 0; n < 2; ++n) acc[a][b][m][n] = (f32x4){0.f, 0.f, 0.f, 0.f};
        cur = nxt; cB0 = nB0; cB1 = nB1; cAu = nAu; ++ui; rmbuf ^= 1;
        if (wr == 1) PG8_BAR;
    }
    PG8_WAIT_V(0);
    PG8_BAR;
#undef PG8_SA
#undef PG8_SB
#undef PG8_STAGE
#undef PG8_DMA
#undef PG8_STAGE_G
#undef PG8_STAGE_B
#undef PG8_RMGET
#undef PG8_STAGE_A
#undef PG8_LDA
#undef PG8_LDB
#undef PG8_MMA
#undef PG8_WAIT_V
#undef PG8_WAIT_L
#undef PG8_BAR
#undef PG8_SCHED
}
}

enum { I_X = 0, I_C, I_CTX, I_CCTX, I_ADAW, I_ADAB, I_NMIX, I_NFFN, I_WIN, I_LBL, I_HNW, I_SNW, I_SGUW, I_SGUB, I_WBA, I_WBB, I_WOUT, I_RW, I_EWG, I_EWU, I_EWD, I_FNW, N_IN };
struct Args { const float* in[N_IN]; float* out; unsigned char* ws; int ph_lo, ph_hi; };
struct InTab { __device__ __forceinline__ const float* operator[](int i) const {
    typedef const float* __attribute__((address_space(4))) const* kptr_t;
    return ((kptr_t)__builtin_amdgcn_kernarg_segment_ptr())[i]; } };
struct Frame {
    LAS unsigned char* lds;
    int tid, lane, wave, G, bid, vcu;
    InTab in;
    float* out; unsigned char* ws;
};
using pg8::Unit;

struct StaticOrder {
    int nM, nN, nwg, G, c;
    __device__ __forceinline__ void init(int nM_, int nN_, int G_, int c_) { nM = nM_; nN = nN_; nwg = nM * nN; G = G_; c = c_; }
    __device__ __forceinline__ bool decode(int L, Unit& u) const {
        int wgid = L; { const int q = nwg / 8, r = nwg % 8, xcd = wgid % 8, off = wgid / 8; wgid = (xcd < r ? xcd * (q + 1) : r * (q + 1) + (xcd - r) * q) + off; }
        const int nig = 8 * nN, gid = wgid / nig, fm = gid * 8, gsz = (nM - fm) < 8 ? (nM - fm) : 8;
        u.pm = fm + ((wgid % nig) % gsz); u.pn = (wgid % nig) / gsz; pg8::std_halves(u); return true;
    }
    __device__ __forceinline__ bool next(int i, Unit& u) const { const long L = (long)i * G + c; if (L >= nwg) return false; return decode((int)L, u); }
};
struct SchedIn {
    int G, c, nct;
    __device__ __forceinline__ void init(int G_, int c_, int nct_) { G = G_; c = c_; nct = nct_; }
    __device__ __forceinline__ bool next(int i, Unit& u) const {
        const int L = i * G + c; if (L >= 128 * nct) return false;
        constexpr int GR = SCHED_GR;
        const int xcd = L & 7, off = L >> 3;
        const int grp = off / (GR * nct), rem = off % (GR * nct);
        u.pm = xcd * 16 + grp * GR + rem % GR; u.pn = (rem / GR + 3 * xcd) % nct; pg8::std_halves(u); return true;
    }
};
struct SchedCtx {
    int b, h, dir;
    __device__ __forceinline__ bool next(int i, Unit& u) const { if (i > 0) return false; u.pm = 128 + b; u.pn = dir * 4 + h; u.b0 = 512 + dir * 512 + h * 128; u.b1 = 1536 + h * 128; return true; }
};
struct SchedMoe1 {
    int G, c;
    __device__ __forceinline__ bool next(int i, Unit& u) const {
        const int L = i * G + c; if (L >= 4096) return false;
        const int e = L >> 8, r = L & 255, xcd = r >> 5, j = r & 31;
        const int rt16 = (xcd >> 1) * 4 + (j >> 3), ct = (xcd & 1) * 8 + (j & 7), b = rt16 >> 2, rt = rt16 & 3;
        u.pm = (b * NE + e) * 4 + rt; u.pn = e * 16 + ct; pg8::std_halves(u); return true;
    }
};
struct SchedMoe2 {
    int G, c;
    __device__ __forceinline__ bool next(int i, Unit& u) const {
        const int L = i * G + c; if (L >= 1024) return false;
        const int e = L >> 6, r = L & 63, rt16 = r >> 2, ct = r & 3, b = rt16 >> 2, rt = rt16 & 3;
        u.pm = (b * NE + e) * 4 + rt; u.pn = e * 4 + ct; pg8::std_halves(u); return true;
    }
};

enum { ACT_NONE = 0, ACT_SILU, ACT_LOGF, ACT_GELU, ACT_SIGM };
template <int MODE> __device__ __forceinline__ float act1(float v, float lb) {
    if (MODE == ACT_SILU) return siluf(v);
    if (MODE == ACT_GELU) return geluf(v);
    if (MODE == ACT_SIGM) return sigm(v);
    if (MODE == ACT_LOGF) return __logf(lb + (1.f - lb) * sigm(v));
    return v;
}
template <int MODE> __device__ __forceinline__ void epi_store_act(const f32x4 (&acc)[2][2][4][2], bf16_t* base, int ld, int row0, int col0, const float* lbp) {
    float lbv[2][8];
#pragma unroll
    for (int bj = 0; bj < 2; ++bj)
#pragma unroll
        for (int j = 0; j < 8; ++j) lbv[bj][j] = (MODE == ACT_LOGF) ? lbp[col0 + bj * 128 + j] : 0.f;
#pragma unroll
    for (int ai = 0; ai < 2; ++ai)
#pragma unroll
        for (int m = 0; m < 4; ++m) { unsigned ro = (unsigned)((row0 + ai * 128 + m * 16) * ld + col0) * 2u; asm volatile("" : "+v"(ro));
            bf16_t* rowp = (bf16_t*)((unsigned char*)base + ro);
#pragma unroll
            for (int bj = 0; bj < 2; ++bj) { const f32x4 v0 = acc[ai][bj][m][0], v1 = acc[ai][bj][m][1];
                u32x4 w;
                w.x = cvt_pk_bf16(act1<MODE>(v0[0], lbv[bj][0]), act1<MODE>(v0[1], lbv[bj][1])); w.y = cvt_pk_bf16(act1<MODE>(v0[2], lbv[bj][2]), act1<MODE>(v0[3], lbv[bj][3]));
                w.z = cvt_pk_bf16(act1<MODE>(v1[0], lbv[bj][4]), act1<MODE>(v1[1], lbv[bj][5])); w.w = cvt_pk_bf16(act1<MODE>(v1[2], lbv[bj][6]), act1<MODE>(v1[3], lbv[bj][7]));
                *(u32x4*)(rowp + bj * 128) = w; } }
}
struct EpiIn {
    static constexpr bool PERM = true;
    unsigned char* ws;
    __device__ __forceinline__ void operator()(const f32x4 (&acc)[2][2][4][2], const Unit& u, int wr, int wc, int fr, int fq) const {
        const int pn = u.pn; const int row0 = u.pm * 256 + wr * 64 + fr; const int cw = wc * 32 + 8 * fq;
        const float* lb = (const float*)(ws + WS_LB);
        if (pn < 2)       epi_store_act<ACT_SILU>(acc, (bf16_t*)(ws + WS_Q), 512, row0, pn * 256 + cw, nullptr);
        else if (pn < 4)  epi_store_act<ACT_LOGF>(acc, (bf16_t*)(ws + WS_FF), 512, row0, (pn - 2) * 256 + cw, lb);
        else if (pn < 6)  epi_store_act<ACT_LOGF>(acc, (bf16_t*)(ws + WS_FB), 512, row0, (pn - 4) * 256 + cw, lb + 512);
        else if (pn < 8)  epi_store_act<ACT_NONE>(acc, (bf16_t*)(ws + WS_V), 512, row0, (pn - 6) * 256 + cw, nullptr);
        else if (pn < 10) epi_store_act<ACT_SILU>(acc, (bf16_t*)(ws + WS_G), 512, row0, (pn - 8) * 256 + cw, nullptr);
        else if (pn < 12) epi_store_act<ACT_GELU>(acc, (bf16_t*)(ws + WS_U), 512, row0, (pn - 10) * 256 + cw, nullptr);
        else              epi_store_act<ACT_GELU>(acc, (bf16_t*)(ws + WS_VS), 512, row0, (pn - 12) * 256 + cw, nullptr);
    }
};
struct EpiGab {
    static constexpr bool PERM = true;
    unsigned char* ws;
    __device__ __forceinline__ void operator()(const f32x4 (&acc)[2][2][4][2], const Unit& u, int wr, int wc, int fr, int fq) const {
        const int row0 = u.pm * 256 + wr * 64 + fr, col0 = u.pn * 128 + wc * 32 + 8 * fq;
        constexpr float SI = -1.f / (SC_H8 * SC_W8);
#pragma unroll
        for (int ai = 0; ai < 2; ++ai)
#pragma unroll
            for (int m = 0; m < 4; ++m) { unsigned ro = (unsigned)((row0 + ai * 128 + m * 16) * 1024 + col0) * 2u; asm volatile("" : "+v"(ro));
                float rr[8], sb[8];
#pragma unroll
                for (int e = 0; e < 8; ++e) { const float ea = __expf(acc[ai][0][m][e >> 2][e & 3] * SI), eb = __expf(acc[ai][1][m][e >> 2][e & 3] * SI);
                    sb[e] = __builtin_amdgcn_rcpf(1.f + eb); rr[e] = (1.f + eb) * __builtin_amdgcn_rcpf(1.f + ea); }
                u32x4 w; w.x = cvt_pk_bf16(rr[0], rr[1]); w.y = cvt_pk_bf16(rr[2], rr[3]); w.z = cvt_pk_bf16(rr[4], rr[5]); w.w = cvt_pk_bf16(rr[6], rr[7]);
                *(u32x4*)(ws + WS_GA + ro) = w;
                w.x = cvt_pk_bf16(sb[0], sb[1]); w.y = cvt_pk_bf16(sb[2], sb[3]); w.z = cvt_pk_bf16(sb[4], sb[5]); w.w = cvt_pk_bf16(sb[6], sb[7]);
                *(u32x4*)(ws + WS_GB + ro) = w; }
    }
};
struct SchedGab {
    SchedIn s;
    __device__ __forceinline__ bool next(int i, Unit& u) const { if (!s.next(i, u)) return false; u.b0 = u.pn * 128; u.b1 = 1024 + u.pn * 128; return true; }
};
struct EpiCtx {
    static constexpr bool PERM = true;
    unsigned char* ws;
    __device__ __forceinline__ void operator()(const f32x4 (&acc)[2][2][4][2], const Unit& u, int wr, int wc, int fr, int fq) const {
        const int dir = u.pn >> 2, h = u.pn & 3; const int row0 = u.pm * 256 + wr * 64 + fr, col0 = h * 128 + wc * 32 + 8 * fq;
        const float* lb = (const float*)(ws + WS_LB) + dir * 512;
        bf16_t* FO = (bf16_t*)(ws + (dir ? WS_FB : WS_FF)); bf16_t* VO = (bf16_t*)(ws + WS_V);
        float lbv[8];
#pragma unroll
        for (int j = 0; j < 8; ++j) lbv[j] = lb[col0 + j];
#pragma unroll
        for (int ai = 0; ai < 2; ++ai)
#pragma unroll
            for (int m = 0; m < 4; ++m) { const size_t ro = (size_t)(row0 + ai * 128 + m * 16) * 512 + col0;
                { const f32x4 v0 = acc[ai][0][m][0], v1 = acc[ai][0][m][1]; u32x4 w;
                  w.x = cvt_pk_bf16(act1<ACT_LOGF>(v0[0], lbv[0]), act1<ACT_LOGF>(v0[1], lbv[1])); w.y = cvt_pk_bf16(act1<ACT_LOGF>(v0[2], lbv[2]), act1<ACT_LOGF>(v0[3], lbv[3]));
                  w.z = cvt_pk_bf16(act1<ACT_LOGF>(v1[0], lbv[4]), act1<ACT_LOGF>(v1[1], lbv[5])); w.w = cvt_pk_bf16(act1<ACT_LOGF>(v1[2], lbv[6]), act1<ACT_LOGF>(v1[3], lbv[7]));
                  *(u32x4*)(FO + ro) = w; }
                { const f32x4 v0 = acc[ai][1][m][0] + 0.f, v1 = acc[ai][1][m][1] + 0.f; u32x4 w;
                  w.x = cvt_pk_bf16(v0[0], v0[1]); w.y = cvt_pk_bf16(v0[2], v0[3]); w.z = cvt_pk_bf16(v1[0], v1[1]); w.w = cvt_pk_bf16(v1[2], v1[3]);
                  *(u32x4*)(VO + ro) = w; } }
    }
};
template <bool ADD> struct EpiGate {
    static constexpr bool PERM = true;
    const bf16_t* gate; const bf16_t* prev; bf16_t* out;
    __device__ __forceinline__ void operator()(const f32x4 (&acc)[2][2][4][2], const Unit& u, int wr, int wc, int fr, int fq) const {
        const int row0 = u.pm * 256 + wr * 64 + fr, col0 = u.pn * 256 + wc * 32 + 8 * fq;
#pragma unroll
        for (int ai = 0; ai < 2; ++ai)
#pragma unroll
            for (int m = 0; m < 4; ++m) { const size_t ro = (size_t)(row0 + ai * 128 + m * 16) * 1024 + col0;
#pragma unroll
                for (int bj = 0; bj < 2; ++bj) { const f32x4 v0 = acc[ai][bj][m][0], v1 = acc[ai][bj][m][1];
                    const u32x4 g = *(const u32x4*)(gate + ro + bj * 128);
                    float r[8] = {v0[0] * bflo(g.x), v0[1] * bfhi(g.x), v0[2] * bflo(g.y), v0[3] * bfhi(g.y), v1[0] * bflo(g.z), v1[1] * bfhi(g.z), v1[2] * bflo(g.w), v1[3] * bfhi(g.w)};
                    if (ADD) { const u32x4 p = *(const u32x4*)(prev + ro + bj * 128);
                        r[0] += bflo(p.x); r[1] += bfhi(p.x); r[2] += bflo(p.y); r[3] += bfhi(p.y); r[4] += bflo(p.z); r[5] += bfhi(p.z); r[6] += bflo(p.w); r[7] += bfhi(p.w); }
                    u32x4 w; w.x = cvt_pk_bf16(r[0], r[1]); w.y = cvt_pk_bf16(r[2], r[3]); w.z = cvt_pk_bf16(r[4], r[5]); w.w = cvt_pk_bf16(r[6], r[7]);
                    *(u32x4*)(out + ro + bj * 128) = w; } }
    }
};
struct HookRatio {
    static constexpr bool ON = true;
    const bf16_t* ratio;
    __device__ __forceinline__ void operator()(f32x4 (&acc)[2][2][4][2], const Unit& u, int wr, int wc, int fr, int fq) const {
        int row0 = u.pm * 256 + wr * 64 + fr, col0 = u.pn * 256 + wc * 32 + 8 * fq;
        asm volatile("" : "+v"(row0), "+v"(col0));
#pragma unroll
        for (int ai = 0; ai < 2; ++ai)
#pragma unroll
            for (int m = 0; m < 4; ++m) { const size_t ro = (size_t)(row0 + ai * 128 + m * 16) * 1024 + col0;
#pragma unroll
                for (int bj = 0; bj < 2; ++bj) { const u32x4 a = __builtin_nontemporal_load((const u32x4*)(ratio + ro + bj * 128));
                    const unsigned aw[4] = {a.x, a.y, a.z, a.w};
#pragma unroll
                    for (int e = 0; e < 4; ++e) { acc[ai][bj][m][e >> 1][2 * (e & 1)] *= bflo(aw[e]); acc[ai][bj][m][e >> 1][2 * (e & 1) + 1] *= bfhi(aw[e]); } }
                asm volatile("" ::: "memory"); }
    }
};
struct EpiX1 {
    static constexpr bool PERM = true;
    const float* x; const float* mod; bf16_t* out;
    __device__ __forceinline__ void operator()(const f32x4 (&acc)[2][2][4][2], const Unit& u, int wr, int wc, int fr, int fq) const {
        const int row0 = u.pm * 256 + wr * 64 + fr, col0 = u.pn * 256 + wc * 32 + 8 * fq;
        const float* gm = mod + (size_t)(u.pm >> 5) * (NMOD * D) + 2 * D;
        f32x4 gv[2][2];
#pragma unroll
        for (int bj = 0; bj < 2; ++bj)
#pragma unroll
            for (int n = 0; n < 2; ++n) gv[bj][n] = *(const f32x4*)(gm + col0 + bj * 128 + 4 * n);
#pragma unroll
        for (int ai = 0; ai < 2; ++ai)
#pragma unroll
            for (int m = 0; m < 4; ++m) { const size_t row = (size_t)(row0 + ai * 128 + m * 16);
#pragma unroll
                for (int bj = 0; bj < 2; ++bj) { const float* xp = x + row * D + col0 + bj * 128;
                    const f32x4 x0 = __builtin_nontemporal_load((const f32x4*)xp), x1v = __builtin_nontemporal_load((const f32x4*)(xp + 4));
                    const f32x4 v0 = x0 + gv[bj][0] * acc[ai][bj][m][0], v1 = x1v + gv[bj][1] * acc[ai][bj][m][1];
                    u32x4 w; w.x = cvt_pk_bf16(v0[0], v0[1]); w.y = cvt_pk_bf16(v0[2], v0[3]); w.z = cvt_pk_bf16(v1[0], v1[1]); w.w = cvt_pk_bf16(v1[2], v1[3]);
                    *(u32x4*)(out + row * (2 * D) + col0 + bj * 128) = w; } }
    }
};
struct EpiHid {
    static constexpr bool PERM = true;
    unsigned char* hid;
    __device__ __forceinline__ void operator()(const f32x4 (&acc)[2][2][4][2], const Unit& u, int wr, int wc, int fr, int fq) const {
        const int row0 = u.pm * 256 + wr * 64 + fr, col0 = (u.pn & 15) * 128 + wc * 32 + 8 * fq;
#pragma unroll
        for (int ai = 0; ai < 2; ++ai)
#pragma unroll
            for (int m = 0; m < 4; ++m) { const f32x4 g0 = acc[ai][0][m][0], g1 = acc[ai][0][m][1], u0 = acc[ai][1][m][0], u1 = acc[ai][1][m][1];
                constexpr float SI = 1.f / (SC_H8 * SC_W8), SO = SC_HID8 / (SC_H8 * SC_W8);
                u32x2 w; w.x = pk4_f8(siluf(g0[0] * SI) * (u0[0] * SO), siluf(g0[1] * SI) * (u0[1] * SO), siluf(g0[2] * SI) * (u0[2] * SO), siluf(g0[3] * SI) * (u0[3] * SO));
                w.y = pk4_f8(siluf(g1[0] * SI) * (u1[0] * SO), siluf(g1[1] * SI) * (u1[1] * SO), siluf(g1[2] * SI) * (u1[2] * SO), siluf(g1[3] * SI) * (u1[3] * SO));
                unsigned off = (unsigned)(row0 + ai * 128 + m * 16) * FF + col0; asm volatile("" : "+v"(off));
                *(u32x2*)(hid + off) = w; }
    }
};
struct EpiYe {
    static constexpr bool PERM = true;
    const float* gate; unsigned char* ye;
    __device__ __forceinline__ void operator()(const f32x4 (&acc)[2][2][4][2], const Unit& u, int wr, int wc, int fr, int fq) const {
        const int row0 = u.pm * 256 + wr * 64 + fr, col0 = (u.pn & 3) * 256 + wc * 32 + 8 * fq;
#pragma unroll
        for (int ai = 0; ai < 2; ++ai)
#pragma unroll
            for (int m = 0; m < 4; ++m) { const int row = row0 + ai * 128 + m * 16; const float gt = gate[row] * (SC_YE8 / (SC_HID8 * SC_W8));
#pragma unroll
                for (int bj = 0; bj < 2; ++bj) { const f32x4 v0 = acc[ai][bj][m][0] * gt, v1 = acc[ai][bj][m][1] * gt;
                    u32x2 w; w.x = pk4_f8(v0[0], v0[1], v0[2], v0[3]); w.y = pk4_f8(v1[0], v1[1], v1[2], v1[3]);
                    unsigned off = (unsigned)row * D + col0 + bj * 128; asm volatile("" : "+v"(off));
                    *(u32x2*)(ye + off) = w; } }
    }
};

constexpr int T64S = 136;
__device__ __forceinline__ void t64_load(f32x4 (&v)[16], const float* src, int ld_src, int lane) {
#pragma unroll
    for (int x = 0; x < 16; ++x) v[x] = __builtin_nontemporal_load((const f32x4*)(src + (size_t)(4 * x + (lane >> 4)) * ld_src + 4 * (lane & 15)));
}
__device__ __forceinline__ void t64_store(const f32x4 (&v)[16], bf16_t* dst, int ld_dst, LAS unsigned char* tile, int lane) {
#pragma unroll
    for (int x = 0; x < 16; ++x) { u32x2 w; w.x = pk2(v[x].x, v[x].y); w.y = pk2(v[x].z, v[x].w); *(LAS u32x2*)(tile + (4 * x + (lane >> 4)) * T64S + 8 * (lane & 15)) = w; }
    LDS_WAIT(); asm volatile("" ::: "memory");
    const int i = lane & 15, grp = lane >> 4, q = i >> 2, p = i & 3;
#pragma unroll
    for (int y = 0; y < 8; ++y) { const int n0 = 16 * (y & 3), kc = grp + 4 * (y >> 2);
        const LAS unsigned char* tp = tile + (8 * kc + q) * T64S + (n0 + 4 * p) * 2;
        typedef short v4i16_t __attribute__((ext_vector_type(4)));
        const v4i16_t lo = __builtin_amdgcn_ds_read_tr16_b64_v4i16((LAS v4i16_t*)tp), hi = __builtin_amdgcn_ds_read_tr16_b64_v4i16((LAS v4i16_t*)(tp + 4 * T64S));
        const bf16x8 o = (bf16x8){lo[0], lo[1], lo[2], lo[3], hi[0], hi[1], hi[2], hi[3]};
        *(GAS bf16x8*)(dst + (size_t)(n0 + i) * ld_dst + 8 * kc) = o; }
    LDS_WAIT(); asm volatile("" ::: "memory");
}
__device__ __forceinline__ void e8_load(f32x4 (&v)[16], const float* src, int ld_src, int lane) {
#pragma unroll
    for (int x = 0; x < 16; ++x) v[x] = __builtin_nontemporal_load((const f32x4*)(src + (size_t)(16 * (lane >> 4) + x) * ld_src + 4 * (lane & 15)));
}
__device__ __forceinline__ void e8_store(const f32x4 (&v)[16], unsigned char* dst, int ld_dst, int lane) {
#pragma unroll
    for (int i = 0; i < 4; ++i) { u32x4 w;
        w.x = pk4_f8(v[0][i] * SC_W8, v[1][i] * SC_W8, v[2][i] * SC_W8, v[3][i] * SC_W8); w.y = pk4_f8(v[4][i] * SC_W8, v[5][i] * SC_W8, v[6][i] * SC_W8, v[7][i] * SC_W8);
        w.z = pk4_f8(v[8][i] * SC_W8, v[9][i] * SC_W8, v[10][i] * SC_W8, v[11][i] * SC_W8); w.w = pk4_f8(v[12][i] * SC_W8, v[13][i] * SC_W8, v[14][i] * SC_W8, v[15][i] * SC_W8);
        *(u32x4*)(dst + (size_t)(4 * (lane & 15) + i) * ld_dst + 16 * (lane >> 4)) = w; }
}
__device__ __forceinline__ void econv_addr(Frame& F, int it, const float*& src, int& ld_src, unsigned char*& dst, int& ld_dst) {
    unsigned char* WGU = F.ws + WS_WGU; unsigned char* WD = F.ws + WS_WD;
    const int which = it >> 13, r = it & 8191, e = r >> 9, q = r & 511;
    if (which < 2) { const int kb = q >> 5, nb = q & 31, n0 = nb * 64; const int drow = (n0 >> 7) * 256 + which * 128 + (n0 & 127);
        src = F.in[which ? I_EWU : I_EWG] + (size_t)e * D * FF + (size_t)(kb * 64) * FF + n0; ld_src = FF; dst = WGU + ((size_t)e * 4096 + drow) * D + kb * 64; ld_dst = D; }
    else { const int kb = q >> 4, nb = q & 15;
        src = F.in[I_EWD] + (size_t)e * FF * D + (size_t)(kb * 64) * D + nb * 64; ld_src = D; dst = WD + ((size_t)e * D + nb * 64) * FF + kb * 64; ld_dst = FF; }
}
__device__ __forceinline__ void econv_drain(Frame& F, unsigned* ctr, int item0, int nitems) {
    constexpr int BATCH = 4;
    for (;;) {
        unsigned base = 0u; if (F.lane == 0) base = atomicAdd(ctr, (unsigned)BATCH);
        base = (unsigned)__builtin_amdgcn_readfirstlane(base);
        if (base >= (unsigned)nitems) break;
        const float* src; int ls; unsigned char* dst; int ld; f32x4 va[16], vb[16];
        econv_addr(F, item0 + (int)base, src, ls, dst, ld); e8_load(va, src, ls, F.lane);
#pragma unroll 1
        for (int j = 0; j < BATCH; j += 2) {
            const float* src2; int ls2; unsigned char* dst2; int ld2; const bool ok2 = (int)base + j + 1 < nitems;
            if (ok2) { econv_addr(F, item0 + (int)base + j + 1, src2, ls2, dst2, ld2); e8_load(vb, src2, ls2, F.lane); }
            e8_store(va, dst, ld, F.lane);
            if (j + 2 < BATCH && (int)base + j + 2 < nitems) { econv_addr(F, item0 + (int)base + j + 2, src, ls, dst, ld); e8_load(va, src, ls, F.lane); }
            if (ok2) e8_store(vb, dst2, ld2, F.lane);
            if ((int)base + j + 2 >= nitems) break;
        }
    }
}
__device__ __forceinline__ void econv_queue(Frame& F) {
    unsigned* ctl = (unsigned*)(F.ws + WS_CTL);
#pragma unroll 1
    for (int qi = 0; qi < 2; ++qi)
        econv_drain(F, ctl + (qi ? CW_QUEUE : CW_QUEUE2), qi ? 0 : 16384 + 7168, qi ? 16384 : 1024);
}

__device__ __forceinline__ void ph_prologue(Frame& F) {
    float* MOD = (float*)(F.ws + WS_MOD);
    if (F.bid < 192) {
        LAS float* sc = (LAS float*)F.lds; LAS float* red = (LAS float*)(F.lds + 20480);
        for (int i = F.tid; i < 5 * D; i += NTHR) { const int r = i >> 10, k = i & 1023; const float cv = (r < 4) ? F.in[I_C][r * D + k] : F.in[I_CCTX][k]; sc[i] = siluf(cv); }
        __syncthreads();
        for (int item = F.bid; item < 192; item += F.G) {
            const int n0 = item * 32, nn = F.tid & 31, kg = F.tid >> 5;
            float a[5] = {0.f, 0.f, 0.f, 0.f, 0.f};
            const float* w = F.in[I_ADAW] + (size_t)(kg * 64) * (NMOD * D) + n0 + nn;
#pragma unroll 8
            for (int kk = 0; kk < 64; ++kk) { const float wv = w[(size_t)kk * (NMOD * D)];
#pragma unroll
                for (int r = 0; r < 5; ++r) a[r] += sc[r * D + kg * 64 + kk] * wv; }
#pragma unroll
            for (int r = 0; r < 5; ++r) red[(kg * 5 + r) * 32 + nn] = a[r];
            __syncthreads();
            if (F.tid < 160) { const int r = F.tid >> 5, n2 = F.tid & 31; float s = F.in[I_ADAB][n0 + n2];
                for (int k2 = 0; k2 < 16; ++k2) s += red[(k2 * 5 + r) * 32 + n2];
                MOD[r * (NMOD * D) + n0 + n2] = s; }
            __syncthreads();
        }
    }
    if (F.bid == F.G - 1) {
        float* LB = (float*)(F.ws + WS_LB);
        for (int i = F.tid; i < 1024; i += NTHR) { const int dir = i >> 9, c = i & 511; const float l0 = F.in[I_LBL][dir * 1024 + c], l1 = F.in[I_LBL][dir * 1024 + 512 + c]; LB[i] = 1.f / (1.f + __expf(l1 - l0)); }
    }
    __syncthreads();
    LAS unsigned char* tile = F.lds + F.wave * 16384;
    const int gw = F.vcu * NWAVES + F.wave, NGW = F.G * NWAVES;
    bf16_t* WIN = (bf16_t*)(F.ws + WS_WIN); bf16_t* WA = (bf16_t*)(F.ws + WS_WA); bf16_t* WB = (bf16_t*)(F.ws + WS_WB); bf16_t* WO = (bf16_t*)(F.ws + WS_WO);
    for (int it = gw; it < 1920; it += NGW) {
        int r = it; f32x4 v[16];
        if (r < 1408) { const int kb = r / 88, nb = r % 88;
            if (nb >= 56) { e8_load(v, F.in[I_WIN] + (size_t)(kb * 64) * INC + nb * 64, INC, F.lane); e8_store(v, F.ws + WS_W8 + (size_t)((nb - 56) * 64) * D + kb * 64, D, F.lane); continue; }
            t64_load(v, F.in[I_WIN] + (size_t)(kb * 64) * INC + nb * 64, INC, F.lane); t64_store(v, WIN + (size_t)(nb * 64) * D + kb * 64, D, tile, F.lane); continue; } r -= 1408;
        if (r < 128) { const int kb = r / 16, nb = r % 16; t64_load(v, F.in[I_WBA] + (size_t)(kb * 64) * D + nb * 64, D, F.lane); t64_store(v, WA + (size_t)(nb * 64) * D + kb * 64, D, tile, F.lane); continue; } r -= 128;
        if (r < 128) { const int kb = r / 16, nb = r % 16; t64_load(v, F.in[I_WBB] + (size_t)(kb * 64) * D + nb * 64, D, F.lane); t64_store(v, WA + (size_t)(nb * 64) * D + 512 + kb * 64, D, tile, F.lane); continue; } r -= 128;
        { const int kb = r / 16, nb = r % 16; t64_load(v, F.in[I_WOUT] + (size_t)(kb * 64) * D + nb * 64, D, F.lane); t64_store(v, WO + (size_t)(nb * 64) * D + kb * 64, D, tile, F.lane); }
    }
}

__device__ __forceinline__ void ph_norm1(Frame& F) {
    const float* MOD = (const float*)(F.ws + WS_MOD); bf16_t* H = (bf16_t*)(F.ws + WS_H); unsigned char* H8 = F.ws + WS_H8;
    const int gw = F.vcu * NWAVES + F.wave, NGW = F.G * NWAVES;
    int curb = -1; f32x4 ca[4], cb[4];
    for (int m = gw; m < MT; m += NGW) {
        const int b = m < ML ? m / T : 4;
        if (b != curb) { curb = b;
#pragma unroll
            for (int j = 0; j < 4; ++j) { const int col = 4 * F.lane + 256 * j; const f32x4 w4 = *(const f32x4*)(F.in[I_NMIX] + col), s4 = *(const f32x4*)(MOD + b * (NMOD * D) + D + col);
                ca[j] = w4 * (s4 + 1.f); cb[j] = *(const f32x4*)(MOD + b * (NMOD * D) + col); } }
        const float* xr = m < ML ? F.in[I_X] + (size_t)m * D : F.in[I_CTX] + (size_t)(m - ML) * D;
        f32x4 v[4]; float ss = 0.f;
#pragma unroll
        for (int j = 0; j < 4; ++j) { v[j] = __builtin_nontemporal_load((const f32x4*)(xr + 4 * F.lane + 256 * j)); ss += (v[j].x * v[j].x + v[j].y * v[j].y) + (v[j].z * v[j].z + v[j].w * v[j].w); }
        const float rstd = rsqrtf(wave_sum(ss) * (1.f / D) + EPS);
#pragma unroll
        for (int j = 0; j < 4; ++j) { const f32x4 o = v[j] * rstd * ca[j] + cb[j]; u32x2 w; w.x = pk2(o.x, o.y); w.y = pk2(o.z, o.w);
            *(u32x2*)(H + (size_t)m * D + 4 * F.lane + 256 * j) = w;
            if (m < ML) *(unsigned*)(H8 + (size_t)m * D + 4 * F.lane + 256 * j) = pk4_f8(o.x * SC_H8, o.y * SC_H8, o.z * SC_H8, o.w * SC_H8); }
    }
}

namespace hg {
constexpr int TS = 136, TILE_B = 64 * TS * 2;
constexpr int OFF_QT = 0, OFF_KT = TILE_B, OFF_VT = 2 * TILE_B, OFF_EM = 3 * TILE_B, OFF_D2 = OFF_EM + 512, BUF_B = 3 * TILE_B + 1024;
constexpr int PS = 72, OFF_P = 2 * BUF_B, OFF_TOT = OFF_P + 64 * PS * 2;
static_assert(OFF_TOT + 2048 <= RING_BYTES, "hg LDS map");
typedef short v4i16_t __attribute__((ext_vector_type(4)));
__device__ __forceinline__ v4i16_t trd(const LAS unsigned char* p) { return __builtin_amdgcn_ds_read_tr16_b64_v4i16((LAS v4i16_t*)p); }
__device__ __forceinline__ bf16x8 cat8(v4i16_t lo, v4i16_t hi) { return (bf16x8){lo[0], lo[1], lo[2], lo[3], hi[0], hi[1], hi[2], hi[3]}; }
#define HG_BAR_LDS() do { asm volatile("s_waitcnt lgkmcnt(0)" ::: "memory"); __builtin_amdgcn_s_barrier(); asm volatile("" ::: "memory"); } while (0)
struct Raw { unsigned lf[16], q[16]; u32x4 v[4]; };
struct PSt { int unused; };

template <bool OUT>
__device__ __forceinline__ void load_raw(Frame& F, Raw& R, const bf16_t* Qb, const bf16_t* Fb, const bf16_t* Vb, int rowbase, int len, int dir, int p0, int h, int pw) {
    asm volatile("" : "+v"(p0));
#pragma unroll
    for (int i = 0; i < 16; ++i) { const int p = p0 + 16 * pw + i, tok = dir ? len - 1 - p : p; const size_t off = (size_t)(rowbase + tok) * HW + h * DK + 2 * F.lane;
        R.lf[i] = *(const unsigned*)(Fb + off); if (OUT) R.q[i] = *(const unsigned*)(Qb + off); }
    { const int pt = F.lane + 64 * pw, r = pt >> 2, qd = pt & 3, p = p0 + r, tok = dir ? len - 1 - p : p; const bf16_t* vp = Vb + (size_t)(rowbase + tok) * HW + h * DK + qd * 32;
#pragma unroll
      for (int x = 0; x < 4; ++x) R.v[x] = *(const u32x4*)(vp + 8 * x); }
}
__device__ __forceinline__ void prep1(Frame& F, const Raw& R, LAS unsigned char* buf, int pw, PSt& P) {
    LAS float* TOT = (LAS float*)(F.lds + OFF_TOT);
    float a0 = 0.f, a1 = 0.f;
#pragma unroll
    for (int i = 0; i < 16; ++i) { a0 += bflo(R.lf[i]); a1 += bfhi(R.lf[i]); }
    *(LAS f32x2*)(TOT + pw * 128 + 2 * F.lane) = (f32x2){a0, a1};
    { const int pt = F.lane + 64 * pw, r = pt >> 2, qd = pt & 3;
#pragma unroll
      for (int x = 0; x < 4; ++x) *(LAS u32x4*)(buf + OFF_VT + (r * TS + qd * 32 + 8 * x) * 2) = R.v[x]; }
}
template <bool OUT>
__device__ __forceinline__ void prep2(Frame& F, const Raw& R, LAS unsigned char* buf, int pw, const PSt& P, float& seg0, float& seg1) {
    const LAS float* TOT = (const LAS float*)(F.lds + OFF_TOT);
    float off0 = 0.f, off1 = 0.f, m0 = 0.f, m1 = 0.f, t0 = 0.f, t1 = 0.f, own0 = 0.f, own1 = 0.f;
#pragma unroll
    for (int g2 = 0; g2 < 4; ++g2) { const f32x2 t = *(const LAS f32x2*)(TOT + g2 * 128 + 2 * F.lane);
        if (g2 < pw) { off0 += t.x; off1 += t.y; } if (g2 == pw) { own0 = t.x; own1 = t.y; } if (g2 < 2) { m0 += t.x; m1 += t.y; } t0 += t.x; t1 += t.y; }
    float f0[16], f1[16];
    float E0 = __expf(fminf(off0 - m0, 80.f)), E1 = __expf(fminf(off1 - m1, 80.f));
#pragma unroll
    for (int i = 0; i < 16; ++i) { f0[i] = __expf(bflo(R.lf[i])); f1[i] = __expf(bfhi(R.lf[i])); E0 *= f0[i]; E1 *= f1[i];
        if (OUT) *(LAS unsigned*)(buf + OFF_QT + ((16 * pw + i) * TS + 2 * F.lane) * 2) = cvt_pk_bf16(bflo(R.q[i]) * E0, bfhi(R.q[i]) * E1); }
    float G0 = __expf(fminf(m0 - (off0 + own0), 80.f)), G1 = __expf(fminf(m1 - (off1 + own1), 80.f));
#pragma unroll
    for (int i = 15; i >= 0; --i) { *(LAS unsigned*)(buf + OFF_KT + ((16 * pw + i) * TS + 2 * F.lane) * 2) = cvt_pk_bf16((1.f - f0[i]) * G0, (1.f - f1[i]) * G1); G0 *= f0[i]; G1 *= f1[i]; }
    if (pw == 0) { *(LAS f32x2*)(buf + OFF_EM + 8 * F.lane) = (f32x2){__expf(m0), __expf(m1)}; *(LAS f32x2*)(buf + OFF_D2 + 8 * F.lane) = (f32x2){__expf(t0 - m0), __expf(t1 - m1)}; }
    seg0 += t0; seg1 += t1;
}
__device__ __forceinline__ void p_tile(Frame& F, const LAS unsigned char* buf, int it, int jt) {
    const int c = F.lane & 15, g = F.lane >> 4;
    f32x4 acc = (f32x4){0.f, 0.f, 0.f, 0.f};
    bf16x8 a[4], b[4];
#pragma unroll
    for (int s = 0; s < 4; ++s) { a[s] = *(const LAS bf16x8*)(buf + OFF_KT + ((16 * jt + c) * TS + 32 * s + 8 * g) * 2); b[s] = *(const LAS bf16x8*)(buf + OFF_QT + ((16 * it + c) * TS + 32 * s + 8 * g) * 2); }
#pragma unroll
    for (int s = 0; s < 4; ++s) acc = __builtin_amdgcn_mfma_f32_16x16x32_bf16(a[s], b[s], acc, 0, 0, 0);
    if (it == jt) {
#pragma unroll
        for (int r = 0; r < 4; ++r) acc[r] = (4 * g + r > c) ? 0.f : acc[r]; }
    u32x2 wv; wv.x = cvt_pk_bf16(acc[0], acc[1]); wv.y = cvt_pk_bf16(acc[2], acc[3]);
    *(LAS u32x2*)(F.lds + OFF_P + ((16 * it + c) * PS + 16 * jt + 4 * g) * 2) = wv;
}
__device__ __forceinline__ void tile_of(int idx, int& it, int& jt) { it = (idx >= 6) ? 3 : (idx >= 3) ? 2 : (idx >= 1) ? 1 : 0; jt = idx - it * (it + 1) / 2; }
__device__ __forceinline__ void m_part1(Frame& F, const LAS unsigned char* buf, int mw, f32x4 (&S)[2][8], f32x4 (&oT)[2][4], bf16x8 (&vf)[2][2]) {
    const int c = F.lane & 15, g = F.lane >> 4;
    { int it, jt; tile_of(mw, it, jt); p_tile(F, buf, it, jt); asm volatile("" ::: "memory"); tile_of(mw + 4, it, jt); p_tile(F, buf, it, jt); asm volatile("" ::: "memory"); if (mw < 2) { tile_of(mw + 8, it, jt); p_tile(F, buf, it, jt); } asm volatile("" ::: "memory"); }
#pragma unroll
    for (int vs = 0; vs < 2; ++vs)
#pragma unroll
        for (int it = 0; it < 4; ++it) oT[vs][it] = (f32x4){0.f, 0.f, 0.f, 0.f};
#pragma unroll
    for (int s = 0; s < 4; ++s) {
        bf16x8 af[2], bq[4];
#pragma unroll
        for (int it = 0; it < 4; ++it) { const LAS unsigned char* qp = buf + OFF_QT + ((16 * it + c) * TS + 32 * s + 4 * g) * 2;
            const u32x2 lo = *(const LAS u32x2*)qp, hi = *(const LAS u32x2*)(qp + 32); bq[it] = __builtin_bit_cast(bf16x8, (u32x4){lo.x, lo.y, hi.x, hi.y}); }
#pragma unroll
        for (int vs = 0; vs < 2; ++vs) { u32x4 aw; aw.x = cvt_pk_bf16(S[vs][2 * s][0], S[vs][2 * s][1]); aw.y = cvt_pk_bf16(S[vs][2 * s][2], S[vs][2 * s][3]); aw.z = cvt_pk_bf16(S[vs][2 * s + 1][0], S[vs][2 * s + 1][1]); aw.w = cvt_pk_bf16(S[vs][2 * s + 1][2], S[vs][2 * s + 1][3]);
            af[vs] = __builtin_bit_cast(bf16x8, aw); }
#pragma unroll
        for (int it = 0; it < 4; ++it) {
            oT[0][it] = __builtin_amdgcn_mfma_f32_16x16x32_bf16(af[0], bq[it], oT[0][it], 0, 0, 0);
            oT[1][it] = __builtin_amdgcn_mfma_f32_16x16x32_bf16(af[1], bq[it], oT[1][it], 0, 0, 0); }
        asm volatile("" ::: "memory");
    }
    const int trow = 8 * g + (c >> 2), tcol = 4 * (c & 3);
#pragma unroll
    for (int vs = 0; vs < 2; ++vs)
#pragma unroll
        for (int js = 0; js < 2; ++js) { const LAS unsigned char* vp = buf + OFF_VT + ((32 * js + trow) * TS + 32 * mw + 16 * vs + tcol) * 2; vf[vs][js] = cat8(trd(vp), trd(vp + 4 * TS * 2)); }
    { bf16x8 kf[8];
#pragma unroll
      for (int t = 0; t < 8; ++t) { const LAS unsigned char* kp = buf + OFF_KT + (trow * TS + 16 * t + tcol) * 2; kf[t] = cat8(trd(kp), trd(kp + 4 * TS * 2)); }
#pragma unroll
      for (int t = 0; t < 8; ++t) {
          S[0][t] = __builtin_amdgcn_mfma_f32_16x16x32_bf16(kf[t], vf[0][0], S[0][t], 0, 0, 0);
          S[1][t] = __builtin_amdgcn_mfma_f32_16x16x32_bf16(kf[t], vf[1][0], S[1][t], 0, 0, 0); } }
}
template <bool OUT>
__device__ __forceinline__ void m_part2(Frame& F, const LAS unsigned char* buf, int mw, f32x4 (&S)[2][8], f32x4 (&oT)[2][4], bf16x8 (&vf)[2][2]) {
    const int c = F.lane & 15, g = F.lane >> 4;
    const int trow = 8 * g + (c >> 2), tcol = 4 * (c & 3);
    if (!OUT) {
#pragma unroll
        for (int vs = 0; vs < 2; ++vs)
#pragma unroll
            for (int js = 0; js < 2; ++js) { const LAS unsigned char* vp = buf + OFF_VT + ((32 * js + trow) * TS + 32 * mw + 16 * vs + tcol) * 2; vf[vs][js] = cat8(trd(vp), trd(vp + 4 * TS * 2)); }
    }
    if (OUT) {
        bf16x8 pb[4][2];
#pragma unroll
        for (int it = 0; it < 4; ++it)
#pragma unroll
            for (int js = 0; js < 2; ++js) if (32 * js <= 16 * it + 15) pb[it][js] = *(const LAS bf16x8*)(F.lds + OFF_P + ((16 * it + c) * PS + 32 * js + 8 * g) * 2);
#pragma unroll
        for (int it = 0; it < 4; ++it)
#pragma unroll
            for (int js = 0; js < 2; ++js) if (32 * js <= 16 * it + 15) {
                oT[0][it] = __builtin_amdgcn_mfma_f32_16x16x32_bf16(vf[0][js], pb[it][js], oT[0][it], 0, 0, 0);
                oT[1][it] = __builtin_amdgcn_mfma_f32_16x16x32_bf16(vf[1][js], pb[it][js], oT[1][it], 0, 0, 0); }
    }
    constexpr int TB = 8;
#pragma unroll
    for (int js = OUT ? 1 : 0; js < 2; ++js)
#pragma unroll
        for (int t0 = 0; t0 < 8; t0 += TB) {
            bf16x8 kf[TB];
#pragma unroll
            for (int t = 0; t < TB; ++t) { const LAS unsigned char* kp = buf + OFF_KT + ((32 * js + trow) * TS + 16 * (t0 + t) + tcol) * 2; kf[t] = cat8(trd(kp), trd(kp + 4 * TS * 2)); }
#pragma unroll
            for (int t = 0; t < TB; ++t) {
                S[0][t0 + t] = __builtin_amdgcn_mfma_f32_16x16x32_bf16(kf[t], vf[0][js], S[0][t0 + t], 0, 0, 0);
                S[1][t0 + t] = __builtin_amdgcn_mfma_f32_16x16x32_bf16(kf[t], vf[1][js], S[1][t0 + t], 0, 0, 0); }
            asm volatile("" ::: "memory");
        }
}
__device__ __forceinline__ void m_scale(Frame& F, const LAS unsigned char* buf, const LAS unsigned char* bufprev, bool hasprev, f32x4 (&S)[2][8]) {
    const int g = F.lane >> 4;
    f32x4 e4[8];
#pragma unroll
    for (int t = 0; t < 8; ++t) e4[t] = *(const LAS f32x4*)(buf + OFF_EM + (16 * t + 4 * g) * 4);
    if (hasprev) {
#pragma unroll
        for (int t = 0; t < 8; ++t) e4[t] *= *(const LAS f32x4*)(bufprev + OFF_D2 + (16 * t + 4 * g) * 4); }
#pragma unroll
    for (int t = 0; t < 8; ++t) { S[0][t] *= e4[t]; S[1][t] *= e4[t]; }
}
__device__ __forceinline__ void m_final_scale(Frame& F, const LAS unsigned char* buf, f32x4 (&S)[2][8]) {
    const int g = F.lane >> 4;
#pragma unroll
    for (int t = 0; t < 8; ++t) { const f32x4 d4 = *(const LAS f32x4*)(buf + OFF_D2 + (16 * t + 4 * g) * 4); S[0][t] *= d4; S[1][t] *= d4; }
}
__device__ __forceinline__ size_t st_idx(int mw, int vs, int t, int lane) { return (size_t)((((mw * 2 + vs) * 8 + t) * 64 + lane) * 4); }

struct ConvSt { f32x4 v[16]; unsigned char* dst; int ld; int have; };
__device__ __forceinline__ void conv_issue(Frame& F, ConvSt& C, int idx) {
    C.have = (idx >= 0 && idx < 8192) ? 1 : 0;
    if (C.have) { const float* src; int ls; econv_addr(F, 16384 + idx, src, ls, C.dst, C.ld); e8_load(C.v, src, ls, F.lane); }
}
__device__ __forceinline__ void conv_finish(Frame& F, ConvSt& C) { if (C.have) { e8_store(C.v, C.dst, C.ld, F.lane); C.have = 0; } }
template <bool OUT>
__device__ __forceinline__ void scan_item(Frame& F, int item) {
    const int seq = item >> 3, part = item & 7, b = seq >> 3, h = (seq >> 1) & 3, dir = seq & 1;
    const bool isctx = !OUT && part == 0;
    const int len = isctx ? CTXL : T, rowbase = isctx ? ML + b * CTXL : b * T, nch = isctx ? 4 : 16, pbeg = OUT ? part * 1024 : (isctx ? 0 : (part - 1) * 1024);
    const bf16_t* Qb = (const bf16_t*)(F.ws + WS_Q); const bf16_t* Fb = (const bf16_t*)(F.ws + (dir ? WS_FB : WS_FF)); const bf16_t* Vb = (const bf16_t*)(F.ws + WS_V);
    bf16_t* OD = (bf16_t*)(F.ws + WS_ODIR) + (size_t)dir * ML * HW;
    const bool isP = F.wave >= 4; const int pw = F.wave & 3, mw = F.wave & 3;
    const int c = F.lane & 15, g = F.lane >> 4;
    f32x4 S[2][8], oT[2][4];
    Raw RA, RB; PSt PS_;
    float seg0 = 0.f, seg1 = 0.f;
    if (isP) { load_raw<OUT>(F, RA, Qb, Fb, Vb, rowbase, len, dir, pbeg, h, pw); }
    else {
        if (OUT) {
            const float* ST = (const float*)(F.ws + WS_STATE) + (size_t)(seq * 8 + part) * 16384;
#pragma unroll
            for (int vs = 0; vs < 2; ++vs)
#pragma unroll
                for (int t = 0; t < 8; ++t) S[vs][t] = *(const f32x4*)(ST + st_idx(mw, vs, t, F.lane));
            { const int half = F.tid >> 7, q = F.tid & 127, row = (half ? 32 : 0) + (q >> 3), col = (half ? 48 : 16) + 2 * (q & 7); *(LAS unsigned*)(F.lds + OFF_P + (row * PS + col) * 2) = 0u; }
        } else {
#pragma unroll
            for (int vs = 0; vs < 2; ++vs)
#pragma unroll
                for (int t = 0; t < 8; ++t) S[vs][t] = (f32x4){0.f, 0.f, 0.f, 0.f};
        }
    }
    if (isP) {
#define HG_P_PERIOD(RCUR, RNXT, n_) do { const int pn_ = (n_); LAS unsigned char* bufp = F.lds + (pn_ & 1) * BUF_B; \
            if (pn_ + 1 < nch) load_raw<OUT>(F, RNXT, Qb, Fb, Vb, rowbase, len, dir, pbeg + 64 * (pn_ + 1), h, pw); \
            if (pn_ < nch) prep1(F, RCUR, bufp, pw, PS_); \
            HG_BAR_LDS(); \
            if (pn_ < nch) prep2<OUT>(F, RCUR, bufp, pw, PS_, seg0, seg1); \
            HG_BAR_LDS(); } while (0)
        for (int n = 0; n <= nch; n += 2) { HG_P_PERIOD(RA, RB, n); if (n + 1 <= nch) HG_P_PERIOD(RB, RA, n + 1); }
#undef HG_P_PERIOD
    } else {
        ConvSt CV; CV.have = 0; CV.dst = nullptr; CV.ld = 0; bf16x8 vfm[2][2];
        for (int n = 0; n <= nch; ++n) {
            const LAS unsigned char* bufm = F.lds + ((n - 1) & 1) * BUF_B;
            if (!OUT) { conv_finish(F, CV); conv_issue(F, CV, (!isctx && (n & 1) && n < 16) ? ((seq * 7 + part - 1) * 4 + mw) * 8 + (n >> 1) : -1); }
            if (n >= 1) m_scale(F, bufm, F.lds + (n & 1) * BUF_B, n >= 2, S);
            if (OUT && n >= 1) m_part1(F, bufm, mw, S, oT, vfm);
            HG_BAR_LDS();
            if (n >= 1) { m_part2<OUT>(F, bufm, mw, S, oT, vfm);
                if (OUT) {
#pragma unroll
                    for (int vs = 0; vs < 2; ++vs)
#pragma unroll
                        for (int it = 0; it < 4; ++it) { const int p = pbeg + 64 * (n - 1) + 16 * it + c, tok = dir ? T - 1 - p : p;
                            u32x2 wv; wv.x = cvt_pk_bf16(oT[vs][it][0], oT[vs][it][1]); wv.y = cvt_pk_bf16(oT[vs][it][2], oT[vs][it][3]);
                            *(u32x2*)(OD + (size_t)(rowbase + tok) * HW + h * DK + 32 * mw + 16 * vs + 4 * g) = wv; } } }
            HG_BAR_LDS();
        }
        if (!OUT) { conv_finish(F, CV); m_final_scale(F, F.lds + ((nch - 1) & 1) * BUF_B, S); }
    }
    if (!OUT) {
        float* ST = (float*)(F.ws + WS_STATE) + (size_t)item * 16384; float* DC = (float*)(F.ws + WS_DEC) + item * 128;
        if (!isP) {
#pragma unroll
            for (int vs = 0; vs < 2; ++vs)
#pragma unroll
                for (int t = 0; t < 8; ++t) *(f32x4*)(ST + st_idx(mw, vs, t, F.lane)) = S[vs][t]; }
        else if (pw == 0) { DC[2 * F.lane] = __expf(seg0); DC[2 * F.lane + 1] = __expf(seg1); }
    }
    HG_BAR_LDS();
}
}

__device__ __forceinline__ void ph_sgu(Frame& F) {
    constexpr int TS = hg::TS; constexpr int OFF_W = 0, OFF_VN = 128 * TS * 2;
    const int g4 = F.bid & 3, c = F.lane & 15, g = F.lane >> 4, w = F.wave;
    const bf16_t* VS = (const bf16_t*)(F.ws + WS_VS); const bf16_t* U = (const bf16_t*)(F.ws + WS_U); bf16_t* AC = (bf16_t*)(F.ws + WS_H);
    { const float* wsrc = F.in[I_SGUW] + (size_t)g4 * 16384;
#pragma unroll
      for (int x = 0; x < 8; ++x) { const int id = F.tid + NTHR * x, row = id >> 5, c4 = id & 31; const f32x4 v = *(const f32x4*)(wsrc + row * 128 + 4 * c4);
          u32x2 o; o.x = pk2(v.x, v.y); o.y = pk2(v.z, v.w); *(LAS u32x2*)(F.lds + OFF_W + (row * TS + 4 * c4) * 2) = o; } }
    for (int bn = (F.bid >> 2); bn < NB * 64; bn += (F.G >> 2)) {
        const int b = bn >> 6, n = bn & 63, rowbase = b * T + n * 128;
        __syncthreads();
        { const int s = F.tid >> 2, part = F.tid & 3; const bf16_t* src = VS + (size_t)(rowbase + s) * SW + g4 * 128 + part * 32;
          float v[32]; float ss = 0.f;
#pragma unroll
          for (int q = 0; q < 4; ++q) { const u32x4 w4 = *(const u32x4*)(src + q * 8); const unsigned ww[4] = {w4.x, w4.y, w4.z, w4.w};
#pragma unroll
              for (int e = 0; e < 4; ++e) { v[q * 8 + 2 * e] = bflo(ww[e]); v[q * 8 + 2 * e + 1] = bfhi(ww[e]); } }
#pragma unroll
          for (int e = 0; e < 32; ++e) ss += v[e] * v[e];
          ss += __shfl_xor(ss, 1); ss += __shfl_xor(ss, 2);
          const float rstd = rsqrtf(ss * (1.f / 128.f) + EPS);
          const float* nw = F.in[I_SNW] + g4 * 128 + part * 32;
#pragma unroll
          for (int q = 0; q < 4; ++q) { u32x4 o; unsigned ow[4];
#pragma unroll
              for (int e = 0; e < 4; ++e) ow[e] = pk2(v[q * 8 + 2 * e] * rstd * nw[q * 8 + 2 * e], v[q * 8 + 2 * e + 1] * rstd * nw[q * 8 + 2 * e + 1]);
              o.x = ow[0]; o.y = ow[1]; o.z = ow[2]; o.w = ow[3];
              *(LAS u32x4*)(F.lds + OFF_VN + (s * TS + part * 32 + q * 8) * 2) = o; } }
        __syncthreads();
        f32x4 acc[8];
#pragma unroll
        for (int ct = 0; ct < 8; ++ct) acc[ct] = (f32x4){0.f, 0.f, 0.f, 0.f};
#pragma unroll
        for (int ks = 0; ks < 4; ++ks) {
            const bf16x8 bw = *(const LAS bf16x8*)(F.lds + OFF_W + ((16 * w + c) * TS + 32 * ks + 8 * g) * 2);
#pragma unroll
            for (int ct = 0; ct < 8; ++ct) { const LAS unsigned char* vp = F.lds + OFF_VN + ((32 * ks + 8 * g + (c >> 2)) * TS + 16 * ct + 4 * (c & 3)) * 2;
                acc[ct] = __builtin_amdgcn_mfma_f32_16x16x32_bf16(hg::cat8(hg::trd(vp), hg::trd(vp + 4 * TS * 2)), bw, acc[ct], 0, 0, 0); }
        }
        const int t = 16 * w + c; const float bs = F.in[I_SGUB][g4 * 128 + t];
#pragma unroll
        for (int ct = 0; ct < 8; ++ct) { const int col = g4 * 128 + 16 * ct + 4 * g;
            const u32x2 uw = *(const u32x2*)(U + (size_t)(rowbase + t) * SW + col);
            u32x2 o; o.x = pk2(bflo(uw.x) * (acc[ct][0] + bs), bfhi(uw.x) * (acc[ct][1] + bs)); o.y = pk2(bflo(uw.y) * (acc[ct][2] + bs), bfhi(uw.y) * (acc[ct][3] + bs));
            *(u32x2*)(AC + (size_t)(rowbase + t) * D + HW + col) = o; }
    }
    __syncthreads();
}
__device__ __forceinline__ void ph_mix_a(Frame& F) {
    bool did = false;
    for (int it = F.bid; it < 256; it += F.G) if ((it & 7) == 0) { did = true;
        const int seq = it >> 3; SchedCtx S{seq >> 3, (seq >> 1) & 3, seq & 1}; EpiCtx E{F.ws};
        pg8::gemm_phase<EpiCtx, SchedCtx, false>(F.lds, (const bf16_t*)(F.ws + WS_H), D, (const bf16_t*)(F.ws + WS_WIN), D, nullptr, S, E);
    }
    if (did) {
        asm volatile("s_waitcnt vmcnt(0)" ::: "memory"); __syncthreads();
        __builtin_amdgcn_fence(__ATOMIC_ACQUIRE, "agent"); asm volatile("s_waitcnt vmcnt(0)" ::: "memory");
    }
    for (int it = F.bid; it < 256; it += F.G) hg::scan_item<false>(F, it);
    ph_sgu(F);
}
__device__ __forceinline__ void ph_prefix(Frame& F) {
    float* STATE = (float*)(F.ws + WS_STATE); const float* DEC = (const float*)(F.ws + WS_DEC);
    for (int gid = F.bid * NTHR + F.tid; gid < 32 * 4096; gid += F.G * NTHR) {
        const int seq = gid >> 12, q = gid & 4095, t = (q >> 6) & 7, g = (q & 63) >> 4;
        float* st = STATE + (size_t)(seq * 8) * 16384 + 4 * q; const float* dc = DEC + (seq * 8) * 128 + 16 * t + 4 * g;
        f32x4 L[8], Dd[8];
#pragma unroll
        for (int j = 0; j < 8; ++j) { L[j] = *(const f32x4*)(st + (size_t)j * 16384); Dd[j] = *(const f32x4*)(dc + j * 128); }
        f32x4 cacc = L[0];
#pragma unroll
        for (int j = 1; j < 8; ++j) { cacc = Dd[j] * cacc + L[j]; *(f32x4*)(st + (size_t)j * 16384) = cacc; }
    }
}
__device__ __forceinline__ void ph_mix_b(Frame& F) {
    for (int it = F.bid; it < 256; it += F.G) hg::scan_item<true>(F, it);
}

__device__ __forceinline__ void ph_combine(Frame& F) {
    const bf16_t* OD = (const bf16_t*)(F.ws + WS_ODIR); const bf16_t* Gb = (const bf16_t*)(F.ws + WS_G); bf16_t* AC = (bf16_t*)(F.ws + WS_H);
    const int gw = F.vcu * NWAVES + F.wave, NGW = F.G * NWAVES; const int c0 = 8 * F.lane;
    float nw[8];
#pragma unroll
    for (int e = 0; e < 8; ++e) nw[e] = F.in[I_HNW][c0 + e];
    for (int m = gw; m < ML; m += NGW) {
        const u32x4 a = __builtin_nontemporal_load((const u32x4*)(OD + (size_t)m * HW + c0)), bq = __builtin_nontemporal_load((const u32x4*)(OD + (size_t)(ML + m) * HW + c0)), gq = __builtin_nontemporal_load((const u32x4*)(Gb + (size_t)m * HW + c0));
        const unsigned aw[4] = {a.x, a.y, a.z, a.w}, bw[4] = {bq.x, bq.y, bq.z, bq.w}, gw4[4] = {gq.x, gq.y, gq.z, gq.w};
        float o[8]; float ss = 0.f;
#pragma unroll
        for (int e = 0; e < 4; ++e) { o[2 * e] = bflo(aw[e]) + bflo(bw[e]); o[2 * e + 1] = bfhi(aw[e]) + bfhi(bw[e]); ss += o[2 * e] * o[2 * e] + o[2 * e + 1] * o[2 * e + 1]; }
        ss += __shfl_xor(ss, 1); ss += __shfl_xor(ss, 2); ss += __shfl_xor(ss, 4); ss += __shfl_xor(ss, 8);
        const float rstd = rsqrtf(ss * (1.f / 128.f) + EPS);
        u32x4 w; unsigned ww[4];
#pragma unroll
        for (int e = 0; e < 4; ++e) ww[e] = pk2(o[2 * e] * rstd * nw[2 * e] * bflo(gw4[e]), o[2 * e + 1] * rstd * nw[2 * e + 1] * bfhi(gw4[e]));
        w.x = ww[0]; w.y = ww[1]; w.z = ww[2]; w.w = ww[3];
        *(u32x4*)(AC + (size_t)m * D + c0) = w;
    }
}

__device__ __forceinline__ void ph_norm2(Frame& F) {
    const float* MOD = (const float*)(F.ws + WS_MOD); unsigned char* H2 = F.ws + WS_H; float* AFF = (float*)(F.ws + WS_AFF);
    LAS float* rwl = (LAS float*)F.lds;
    LAS float* cab = (LAS float*)(F.lds + 81920);
    { f32x4 w[8]; const float* rwg = F.in[I_RW];
#pragma unroll
        for (int u = 0; u < 8; ++u) w[u] = *(const f32x4*)(rwg + 4 * (F.tid + NTHR * u));
#pragma unroll
        for (int u = 0; u < 8; ++u) { const int idx = 4 * (F.tid + NTHR * u), k = idx >> 4, n = idx & 15; LAS float* p = rwl + (((k >> 6) * 4 + ((k >> 4) & 3)) * 16 + n) * 20 + (k & 15);
            p[0] = w[u].x; p[20] = w[u].y; p[40] = w[u].z; p[60] = w[u].w; }
        f32x4 nw[2], sc[2], sh[2]; const float* nfg = F.in[I_NFFN];
#pragma unroll
        for (int u = 0; u < 2; ++u) { const int idx = 4 * (F.tid + NTHR * u), b = idx >> 10, col = idx & 1023;
            nw[u] = *(const f32x4*)(nfg + col); sc[u] = *(const f32x4*)(MOD + b * (NMOD * D) + 4 * D + col); sh[u] = *(const f32x4*)(MOD + b * (NMOD * D) + 3 * D + col); }
#pragma unroll
        for (int u = 0; u < 2; ++u) { const int idx = 4 * (F.tid + NTHR * u), b = idx >> 10, col = idx & 1023;
            *(LAS f32x4*)(cab + (b * 2) * D + col) = nw[u] * (sc[u] + 1.f); *(LAS f32x4*)(cab + (b * 2 + 1) * D + col) = sh[u]; } }
    __syncthreads();
    const int gw = F.vcu * NWAVES + F.wave, NGW = F.G * NWAVES;
    const int r = F.lane & 15, q = F.lane >> 4;
    for (int tile = gw; tile < ML / 16; tile += NGW) {
        const int R0 = tile * 16, b = R0 / T;
        const bf16_t* xr = (const bf16_t*)F.out + (size_t)(R0 + r) * (2 * D) + 16 * q;
        u32x4 raw[16][2];
#pragma unroll
        for (int i = 0; i < 16; ++i) { raw[i][0] = *(const u32x4*)(xr + 64 * i); raw[i][1] = *(const u32x4*)(xr + 64 * i + 8); }
        float ss = 0.f;
#pragma unroll
        for (int i = 0; i < 16; ++i)
#pragma unroll
            for (int hq = 0; hq < 2; ++hq) { const unsigned ww[4] = {raw[i][hq].x, raw[i][hq].y, raw[i][hq].z, raw[i][hq].w};
#pragma unroll
                for (int e = 0; e < 4; ++e) { const float x0 = bflo(ww[e]), x1 = bfhi(ww[e]); ss += x0 * x0 + x1 * x1; } }
        ss += __shfl_xor(ss, 16); ss += __shfl_xor(ss, 32);
        const float rstd = rsqrtf(ss * (1.f / D) + EPS);
        const LAS float* cap = cab + (b * 2) * D + 16 * q; const LAS float* rwp = rwl + (q * 16 + r) * 20;
        unsigned char* hp = H2 + (size_t)(R0 + r) * D + 16 * q;
        f32x4 acc = {0.f, 0.f, 0.f, 0.f};
        f32x4 can = *(const LAS f32x4*)cap, cbn = *(const LAS f32x4*)(cap + D), wn = *(const LAS f32x4*)rwp;
        u32x4 o8;
#pragma unroll
        for (int g = 0; g < 64; ++g) {
            const int i = g >> 2, c4 = g & 3;
            const f32x4 ca4 = can, cb4 = cbn, w4 = wn;
            if (g + 1 < 64) { const int i1 = (g + 1) >> 2, c1 = (g + 1) & 3;
                can = *(const LAS f32x4*)(cap + 64 * i1 + 4 * c1); cbn = *(const LAS f32x4*)(cap + D + 64 * i1 + 4 * c1); wn = *(const LAS f32x4*)(rwp + i1 * (4 * 16 * 20) + 4 * c1); }
            unsigned r0 = (c4 & 1) ? raw[i][c4 >> 1].z : raw[i][c4 >> 1].x, r1 = (c4 & 1) ? raw[i][c4 >> 1].w : raw[i][c4 >> 1].y;
            asm volatile("" : "+v"(r0), "+v"(r1));
            const f32x4 x4 = {bflo(r0), bfhi(r0), bflo(r1), bfhi(r1)};
            const f32x4 h4 = x4 * rstd * ca4 + cb4;
            o8[c4] = pk4_f8(h4.x * SC_H8, h4.y * SC_H8, h4.z * SC_H8, h4.w * SC_H8);
            acc = __builtin_amdgcn_mfma_f32_16x16x4f32(h4.x, w4.x, acc, 0, 0, 0); acc = __builtin_amdgcn_mfma_f32_16x16x4f32(h4.y, w4.y, acc, 0, 0, 0);
            acc = __builtin_amdgcn_mfma_f32_16x16x4f32(h4.z, w4.z, acc, 0, 0, 0); acc = __builtin_amdgcn_mfma_f32_16x16x4f32(h4.w, w4.w, acc, 0, 0, 0);
            if (c4 == 3) *(u32x4*)(hp + 64 * i) = o8;
            asm volatile("" ::: "memory");
        }
#pragma unroll
        for (int g = 0; g < 4; ++g) {
            float mx = acc[g];
            mx = fmaxf(mx, __shfl_xor(mx, 1)); mx = fmaxf(mx, __shfl_xor(mx, 2)); mx = fmaxf(mx, __shfl_xor(mx, 4)); mx = fmaxf(mx, __shfl_xor(mx, 8));
            const float ex = __expf(acc[g] - mx);
            float den = ex; den += __shfl_xor(den, 1); den += __shfl_xor(den, 2); den += __shfl_xor(den, 4); den += __shfl_xor(den, 8);
            AFF[(size_t)(R0 + 4 * q + g) * NE + r] = ex / den;
        }
    }
}

__device__ __forceinline__ void ph_topk(Frame& F) {
    LAS unsigned* cnt = (LAS unsigned*)F.lds;
    const float* AFF = (const float*)(F.ws + WS_AFF); int* SLOT = (int*)(F.ws + WS_SLOT); int* ROWMAP = (int*)(F.ws + WS_ROWMAP); float* GATE = (float*)(F.ws + WS_GATE);
    for (int item = F.bid; item < NB * NE; item += F.G) {
        const int b = item >> 4, e = item & 15;
        unsigned key[16];
#pragma unroll
        for (int j = 0; j < 16; ++j) key[j] = __builtin_bit_cast(unsigned, AFF[(size_t)(b * T + F.tid * 16 + j) * NE + e]);
        unsigned thr = 0u;
#pragma unroll 1
        for (int bit = 31; bit >= 0; --bit) {
            const unsigned cand = thr | (1u << bit); unsigned c = 0u;
#pragma unroll
            for (int j = 0; j < 16; ++j) c += (key[j] >= cand) ? 1u : 0u;
#pragma unroll
            for (int o = 1; o < 64; o <<= 1) c += __shfl_xor(c, o);
            LAS unsigned* slot = cnt + (bit & 1) * 8;
            if (F.lane == 0) slot[F.wave] = c;
            __syncthreads();
            unsigned tot = 0u;
#pragma unroll
            for (int w = 0; w < 8; ++w) tot += slot[w];
            if (tot >= (unsigned)CAP) thr = cand;
        }
        unsigned cg = 0u, ce = 0u;
#pragma unroll
        for (int j = 0; j < 16; ++j) { cg += (key[j] > thr) ? 1u : 0u; ce += (key[j] == thr) ? 1u : 0u; }
        unsigned ig = cg, ie = ce;
#pragma unroll
        for (int o = 1; o < 64; o <<= 1) { const unsigned tg = __shfl_up(ig, o), te = __shfl_up(ie, o); if (F.lane >= o) { ig += tg; ie += te; } }
        if (F.lane == 63) { cnt[32 + F.wave] = ig; cnt[40 + F.wave] = ie; }
        __syncthreads();
        unsigned pg = ig - cg, pe = ie - ce, total_gt = 0u;
        for (int w = 0; w < 8; ++w) { const unsigned wg = cnt[32 + w]; total_gt += wg; if (w < F.wave) { pg += wg; pe += cnt[40 + w]; } }
        const unsigned want_eq = CAP - total_gt;
#pragma unroll
        for (int j = 0; j < 16; ++j) { const int i = F.tid * 16 + j; const unsigned k = key[j]; int slot = -1;
            if (k > thr) slot = (int)(pg++);
            else if (k == thr) { const unsigned r = pe++; if (r < want_eq) slot = (int)(total_gt + r); }
            SLOT[(size_t)(b * T + i) * NE + e] = slot;
            if (slot >= 0) { ROWMAP[item * CAP + slot] = b * T + i; GATE[item * CAP + slot] = __builtin_bit_cast(float, k); } }
        __syncthreads();
    }
}

__device__ __forceinline__ void ph_final(Frame& F) {
    const float* MOD = (const float*)(F.ws + WS_MOD); const unsigned char* YE = F.ws + WS_YE; const int* SLOT = (const int*)(F.ws + WS_SLOT);
    const int gw = F.vcu * NWAVES + F.wave, NGW = F.G * NWAVES;
    f32x4 fw[4];
#pragma unroll
    for (int j = 0; j < 4; ++j) fw[j] = *(const f32x4*)(F.in[I_FNW] + 4 * F.lane + 256 * j);
    for (int m = gw; m < ML; m += NGW) {
        const int b = m / T;
        float* xr = F.out + (size_t)m * D;
        f32x4 v[4], mo[4];
#pragma unroll
        for (int j = 0; j < 4; ++j) { const u32x2 w = *(const u32x2*)((const bf16_t*)xr + 4 * F.lane + 256 * j); v[j] = (f32x4){bflo(w.x), bfhi(w.x), bflo(w.y), bfhi(w.y)}; mo[j] = (f32x4){0.f, 0.f, 0.f, 0.f}; }
        const int sl = (F.lane < NE) ? SLOT[(size_t)m * NE + F.lane] : -1;
        for (int e = 0; e < NE; ++e) { const int s = __shfl(sl, e);
            if (s >= 0) { const unsigned char* yr = YE + ((size_t)(b * NE + e) * CAP + s) * D;
#pragma unroll
                for (int j = 0; j < 4; ++j) mo[j] += f8x4_f32(*(const unsigned*)(yr + 4 * F.lane + 256 * j)); } }
        float ss = 0.f;
#pragma unroll
        for (int j = 0; j < 4; ++j) { const f32x4 gf = *(const f32x4*)(MOD + b * (NMOD * D) + 5 * D + 4 * F.lane + 256 * j) * (1.f / SC_YE8); v[j] += gf * mo[j]; ss += (v[j].x * v[j].x + v[j].y * v[j].y) + (v[j].z * v[j].z + v[j].w * v[j].w); }
        const float rstd = rsqrtf(wave_sum(ss) * (1.f / D) + EPS);
#pragma unroll
        for (int j = 0; j < 4; ++j) *(f32x4*)(xr + 4 * F.lane + 256 * j) = v[j] * rstd * fw[j];
    }
}

constexpr int N_PHASES = 14;
#ifndef SCHED_GR
#define SCHED_GR 2
#endif
__global__ void __launch_bounds__(NTHR, 2) skel_fwd(Args args) {
    extern __shared__ __attribute__((aligned(16))) unsigned char lds_raw[];
    Frame F;
    F.lds = (LAS unsigned char*)lds_raw;
    F.tid = threadIdx.x; F.lane = F.tid & 63; F.wave = __builtin_amdgcn_readfirstlane(F.tid >> 6);
    F.G = gridDim.x; F.bid = blockIdx.x; F.vcu = (F.G % 8 == 0) ? (F.bid % 8) * (F.G / 8) + F.bid / 8 : F.bid;
    F.out = args.out; F.ws = args.ws;
    volatile LAS unsigned* MISC = (volatile LAS unsigned*)(F.lds + MISC_OFF);
    for (int u = F.tid; u < (LDS_BYTES - LDSCTL_OFF) / 4; u += NTHR) ((LAS unsigned*)(F.lds + LDSCTL_OFF))[u] = 0u;
    __syncthreads();
    XcdBarrier bar; bar.bar = (unsigned*)(F.ws + WS_CTL) + CW_BAR; bar.x = 0; bar.st = nullptr;
#if !MK_PER_PHASE
    bar = xcd_barrier_post((unsigned*)(F.ws + WS_CTL) + CW_BAR, MISC + 8);
#endif
    const int lo = args.ph_lo, hi = args.ph_hi;
#ifndef PH_MASK
#define PH_MASK 0x3fff
#endif
#define IN(k) (((PH_MASK >> (k)) & 1) && lo <= (k) && (k) < hi)
#define SEAM(k) do { if (IN(k) && IN((k) + 1)) xcd_barrier(bar); } while (0)
    if (IN(0)) { ph_prologue(F); } SEAM(0);
    if (IN(1)) { ph_norm1(F); } SEAM(1);
    if (IN(2)) { { SchedIn S; S.init(F.G, F.bid, 14); EpiIn E{F.ws};
            pg8::gemm_phase<EpiIn, SchedIn, false>(F.lds, (const bf16_t*)(F.ws + WS_H), D, (const bf16_t*)(F.ws + WS_WIN), D, nullptr, S, E); }
        { SchedGab S; S.s.init(F.G, F.bid, 8); EpiGab E{F.ws};
            pg8::gemm_phase<EpiGab, SchedGab, false, pg8::NoHook, true>(F.lds, (const bf16_t*)(F.ws + WS_H8), D / 2, (const bf16_t*)(F.ws + WS_W8), D / 2, nullptr, S, E); } } SEAM(2);
    if (IN(3)) { ph_mix_a(F); } SEAM(3);
    if (IN(4)) { ph_prefix(F); } SEAM(4);
    if (IN(5)) { ph_mix_b(F); } SEAM(5);
    if (IN(6)) { ph_combine(F); } SEAM(6);
    if (IN(7)) { StaticOrder S; S.init(128, 4, F.G, F.bid); EpiGate<false> E{(const bf16_t*)(F.ws + WS_GB), nullptr, (bf16_t*)(F.ws + WS_MERGED)}; HookRatio HK{(const bf16_t*)(F.ws + WS_GA)};
        pg8::gemm_phase<EpiGate<false>, StaticOrder, false, HookRatio>(F.lds, (const bf16_t*)(F.ws + WS_H), D, (const bf16_t*)(F.ws + WS_WA), D, nullptr, S, E, HK); } SEAM(7);
    if (IN(8)) { StaticOrder S; S.init(128, 4, F.G, F.bid); EpiX1 E{F.in[I_X], (const float*)(F.ws + WS_MOD), (bf16_t*)F.out};
        pg8::gemm_phase<EpiX1, StaticOrder, false>(F.lds, (const bf16_t*)(F.ws + WS_MERGED), D, (const bf16_t*)(F.ws + WS_WO), D, nullptr, S, E); } SEAM(8);
    if (IN(9)) { ph_norm2(F); } SEAM(9);
    if (IN(10)) { ph_topk(F); econv_queue(F); } SEAM(10);
    if (IN(11)) { SchedMoe1 S{F.G, F.vcu}; EpiHid E{F.ws + WS_HID};
        pg8::gemm_phase<EpiHid, SchedMoe1, true, pg8::NoHook, true>(F.lds, (const bf16_t*)(F.ws + WS_H), D / 2, (const bf16_t*)(F.ws + WS_WGU), D / 2, (const int*)(F.ws + WS_ROWMAP), S, E); } SEAM(11);
    if (IN(12)) { SchedMoe2 S{F.G, F.vcu}; EpiYe E{(const float*)(F.ws + WS_GATE), F.ws + WS_YE};
        pg8::gemm_phase<EpiYe, SchedMoe2, false, pg8::NoHook, true>(F.lds, (const bf16_t*)(F.ws + WS_HID), FF / 2, (const bf16_t*)(F.ws + WS_WD), FF / 2, nullptr, S, E); } SEAM(12);
    if (IN(13)) { ph_final(F); }
#undef IN
#undef SEAM
}

extern "C" void kernel_launch(void* const* d_in, const int* in_sizes, int n_in, void* d_out, int out_size, void* d_ws, size_t ws_size, hipStream_t stream) {
    static int grid = 0;
    if (grid == 0) {
        if (n_in != N_IN || in_sizes[0] != ML * D || out_size != ML * D || ws_size < WS_END) { fprintf(stderr, "kernel_launch: unexpected shapes (n_in %d, in0 %d, out %d, ws %zu < %zu); nothing launched\n", n_in, n_in > 0 ? in_sizes[0] : -1, out_size, ws_size, (size_t)WS_END); grid = -1; return; }
        int dev = 0, cus = 0, per_cu = 0;
        if (hipGetDevice(&dev) != hipSuccess || hipDeviceGetAttribute(&cus, hipDeviceAttributeMultiprocessorCount, dev) != hipSuccess) { grid = -1; return; }
        if (hipFuncSetAttribute((const void*)skel_fwd, hipFuncAttributeMaxDynamicSharedMemorySize, LDS_BYTES) != hipSuccess) { fprintf(stderr, "kernel_launch: hipFuncSetAttribute failed\n"); grid = -1; return; }
        if (hipOccupancyMaxActiveBlocksPerMultiprocessor(&per_cu, (const void*)skel_fwd, NTHR, LDS_BYTES) != hipSuccess || per_cu < 1) fprintf(stderr, "kernel_launch: occupancy query says %d\n", per_cu);
        (void)hipGetLastError();
        grid = cus;
    }
    if (grid < 0) return;
    if (hipMemsetAsync((char*)d_ws + WS_CTL, 0, CTL_ZERO_BYTES, stream) != hipSuccess) return;
    Args a{};
    for (int i = 0; i < N_IN; ++i) a.in[i] = (const float*)d_in[i];
    a.out = (float*)d_out; a.ws = (unsigned char*)d_ws;
#if MK_PER_PHASE
#ifndef DBG_NPH
#define DBG_NPH N_PHASES
#endif
    for (int p = 0; p < DBG_NPH; ++p) { a.ph_lo = p; a.ph_hi = p + 1; hipLaunchKernelGGL(skel_fwd, dim3(grid), dim3(NTHR), LDS_BYTES, stream, a); }
#else
    a.ph_lo = 0; a.ph_hi = N_PHASES; hipLaunchKernelGGL(skel_fwd, dim3(grid), dim3(NTHR), LDS_BYTES, stream, a);
#endif
}
```

```cpp
#include <hip/hip_runtime.h>
#include <cstdio>
#include <cstdint>

#ifndef SCHED_GR
#define SCHED_GR 2
#endif
#ifndef MK_PER_PHASE
#define MK_PER_PHASE 0
#endif

#define GAS __attribute__((address_space(1)))
#define LAS __attribute__((address_space(3)))
typedef unsigned short bf16_t;
typedef short bf16x8 __attribute__((ext_vector_type(8)));
typedef float f32x4 __attribute__((ext_vector_type(4)));
typedef float f32x2 __attribute__((ext_vector_type(2)));
typedef unsigned u32x4 __attribute__((ext_vector_type(4)));
typedef unsigned u32x2 __attribute__((ext_vector_type(2)));
typedef GAS unsigned gu32;

constexpr int D = 1024, NB = 4, T = 8192, ML = NB * T  , CTXL = 256, MC = NB * CTXL  , MT = ML + MC  ;
constexpr int NH = 4, DK = 128, HW = 512, SW = 512, NE = 16, FF = 2048, CAP = 1024, NMOD = 6, INC = 5632;
constexpr float EPS = 1e-6f;
constexpr int NWAVES = 8, NTHR = 512;

constexpr size_t MiB = 1u << 20;
constexpr size_t WS_CTL = 0, CTL_ZERO_BYTES = 1 * MiB;
constexpr size_t WS_MOD = 1 * MiB;
constexpr size_t WS_LB = 1 * MiB + 256 * 1024;
constexpr size_t WS_WIN = 2 * MiB;
constexpr size_t WS_WA = 13 * MiB, WS_WB = 14 * MiB, WS_WO = 15 * MiB;
constexpr size_t WS_AFF = 17 * MiB;
constexpr size_t WS_ROWMAP = 19 * MiB;
constexpr size_t WS_GATE = 19 * MiB + 512 * 1024;
constexpr size_t WS_SLOT = 20 * MiB;
constexpr size_t WS_STATE = 22 * MiB;
constexpr size_t WS_DEC = 40 * MiB;
constexpr size_t WS_H = 48 * MiB;
constexpr size_t WS_Q = 114 * MiB, WS_FF = 147 * MiB, WS_FB = 180 * MiB, WS_V = 213 * MiB;
constexpr size_t WS_G = 246 * MiB, WS_U = 278 * MiB, WS_VS = 310 * MiB;
constexpr size_t WS_GA = 342 * MiB, WS_GB = 406 * MiB;
constexpr size_t WS_ODIR = 278 * MiB;
constexpr size_t WS_T = 180 * MiB;
constexpr size_t WS_MERGED = 114 * MiB;
constexpr size_t WS_WGU = 114 * MiB;
constexpr size_t WS_YE = 114 * MiB;
constexpr size_t WS_WD = 498 * MiB;
constexpr size_t WS_HID = 242 * MiB;
constexpr size_t WS_H8 = 530 * MiB;
constexpr size_t WS_W8 = WS_WIN + (size_t)3584 * 2048;
constexpr size_t WS_END = 562 * MiB;

constexpr int CW_BAR = 4096, CW_QUEUE = 8192, CW_QUEUE2 = 8192 + 64;

constexpr int RING_BYTES = 131072;
constexpr int CONV_OFF = 118784;
constexpr int LDSCTL_OFF = 155648, MISC_OFF = LDSCTL_OFF + 320, RM_OFF = LDSCTL_OFF + 2048;
constexpr int LDS_BYTES = 159744;

#define RLX_AGENT __ATOMIC_RELAXED, __HIP_MEMORY_SCOPE_AGENT
#define LDS_WAIT() asm volatile("s_waitcnt lgkmcnt(0)" ::: "memory")
#define VM_WAIT() asm volatile("s_waitcnt vmcnt(0)" ::: "memory")
__device__ __forceinline__ unsigned f2bf(float f) { unsigned u = __builtin_bit_cast(unsigned, f); return (u + 0x7fffu + ((u >> 16) & 1u)) >> 16; }
__device__ __forceinline__ unsigned pk2(float lo, float hi) { return f2bf(lo) | (f2bf(hi) << 16); }
__device__ __forceinline__ float bf2f(unsigned short h) { return __builtin_bit_cast(float, (unsigned)h << 16); }
__device__ __forceinline__ float bflo(unsigned w) { return __builtin_bit_cast(float, w << 16); }
__device__ __forceinline__ float bfhi(unsigned w) { return __builtin_bit_cast(float, w & 0xffff0000u); }
typedef __bf16 bf16x2_t __attribute__((ext_vector_type(2)));
__device__ __forceinline__ unsigned cvt_pk_bf16(float lo, float hi) { f32x2 v = {lo, hi}; bf16x2_t b = __builtin_convertvector(v, bf16x2_t); return __builtin_bit_cast(unsigned, b); }
__device__ __forceinline__ float clamp448(float v) { return copysignf(fminf(fabsf(v), 448.f), v); }
__device__ __forceinline__ unsigned pk4_f8(float a, float b, float c, float d) {
    const float a1 = clamp448(a);
    const int w = __builtin_amdgcn_cvt_pk_fp8_f32(a1, clamp448(b), __builtin_bit_cast(int, a1), false);
    return (unsigned)__builtin_amdgcn_cvt_pk_fp8_f32(clamp448(c), clamp448(d), w, true);
}
__device__ __forceinline__ unsigned pk4_f8m(float a, float b, float c, float d) {
    const float a1 = __builtin_amdgcn_fmed3f(a, -448.f, 448.f);
    const int w = __builtin_amdgcn_cvt_pk_fp8_f32(a1, __builtin_amdgcn_fmed3f(b, -448.f, 448.f), __builtin_bit_cast(int, a1), false);
    return (unsigned)__builtin_amdgcn_cvt_pk_fp8_f32(__builtin_amdgcn_fmed3f(c, -448.f, 448.f), __builtin_amdgcn_fmed3f(d, -448.f, 448.f), w, true);
}
constexpr float SC_W8 = 1024.f, SC_H8 = 16.f, SC_HID8 = 8.f, SC_YE8 = 64.f;
__device__ __forceinline__ f32x4 f8x4_f32(unsigned w) { const f32x2 lo = __builtin_amdgcn_cvt_pk_f32_fp8((int)w, false), hi = __builtin_amdgcn_cvt_pk_f32_fp8((int)w, true); return (f32x4){lo[0], lo[1], hi[0], hi[1]}; }
__device__ __forceinline__ float sigm(float x) { return __builtin_amdgcn_rcpf(1.f + __expf(-x)); }
__device__ __forceinline__ float siluf(float x) { return x * sigm(x); }
__device__ __forceinline__ float geluf(float x) { return x * sigm(1.5957691216057308f * (x + 0.044715f * x * x * x)); }
__device__ __forceinline__ float wave_sum(float v) {
#pragma unroll
    for (int o = 1; o < 64; o <<= 1) v += __shfl_xor(v, o);
    return v;
}

#define XB_TMO      128
#define XB_XCNT(j)  (256  + 64 * (j))
#define XB_XSUB(j)  (1280 + 64 * (j))
#define XB_XGEN(j)  (2304 + 64 * (j))
#define XB_TOP      3328
#define XB_TOPGEN   3392
#define XCD_BAR_WORDS 3456
#define XB_SPIN_CAP (1u << 20)
__device__ __forceinline__ unsigned xb_ld(unsigned* p)              { return __hip_atomic_load(p, __ATOMIC_RELAXED, __HIP_MEMORY_SCOPE_AGENT); }
__device__ __forceinline__ unsigned xb_add(unsigned* p, unsigned v) { return __hip_atomic_fetch_add(p, v, __ATOMIC_RELAXED, __HIP_MEMORY_SCOPE_AGENT); }
__device__ __forceinline__ unsigned xb_xcc_id() { return (unsigned)__builtin_amdgcn_s_getreg((3 << 11) | 20) & 0xFu; }
#define XB_SPIN(cond, bar) do { unsigned _sp = 0; while (cond) { __builtin_amdgcn_s_sleep(1); \
    if ((++_sp & 255u) == 0u) { if (xb_ld(&(bar)[XB_TMO])) break; if (_sp > XB_SPIN_CAP) { atomicAdd(&(bar)[XB_TMO], 1u); break; } } } } while (0)
struct XcdBarrier { unsigned* bar; unsigned x; volatile LAS unsigned* st; };
__device__ __forceinline__ XcdBarrier xcd_barrier_post(unsigned* bar, volatile LAS unsigned* st) {
    XcdBarrier b; b.bar = bar; b.x = xb_xcc_id(); b.st = st;
    if (threadIdx.x == 0) (void)xb_add(&bar[XB_XCNT(b.x)], 1u);
    return b;
}
__device__ __forceinline__ void xcd_barrier_complete(unsigned* bar, unsigned x, unsigned& nloc, unsigned& nx, unsigned& mask) {
    const unsigned G = gridDim.x * gridDim.y * gridDim.z;
    unsigned sum, cnt, mine, sp = 0u;
    for (;;) {
        sum = 0u; cnt = 0u; mine = 0u; mask = 0u;
#pragma unroll
        for (unsigned j = 0; j < 16; ++j) { const unsigned c = xb_ld(&bar[XB_XCNT(j)]); sum += c; cnt += (c > 0u) ? 1u : 0u; mask |= (c > 0u) ? (1u << j) : 0u; mine = (j == x) ? c : mine; }
        if (sum == G) break;
        __builtin_amdgcn_s_sleep(1);
        if ((++sp & 255u) == 0u) { if (xb_ld(&bar[XB_TMO])) break; if (sp > XB_SPIN_CAP) { atomicAdd(&bar[XB_TMO], 1u); break; } }
    }
    nloc = mine > 0u ? mine : 1u; nx = cnt > 0u ? cnt : 1u;
}
__device__ __forceinline__ void xcd_barrier(const XcdBarrier& b) {
    asm volatile("s_waitcnt vmcnt(0)" ::: "memory");
    __syncthreads();
    if (threadIdx.x == 0) {
        unsigned* bar = b.bar;
        __builtin_amdgcn_s_waitcnt(0);
        unsigned nloc = b.st[0], nx = b.st[1], xmask = b.st[2];
        if (nloc == 0u) { xcd_barrier_complete(bar, b.x, nloc, nx, xmask); b.st[0] = nloc; b.st[1] = nx; b.st[2] = xmask; }
        const unsigned old = xb_add(&bar[XB_XSUB(b.x)], 1u);
        const unsigned gen = old / nloc;
        if (old + 1u == (gen + 1u) * nloc) {
            __builtin_amdgcn_fence(__ATOMIC_RELEASE, "agent");
            asm volatile("s_waitcnt vmcnt(0)" ::: "memory");
#pragma unroll
            for (unsigned j = 0; j < 16; ++j) if ((xmask >> j) & 1u) xb_add(&bar[XB_XGEN(j)], 1u);
            asm volatile("buffer_inv sc1" ::: "memory");
            XB_SPIN((int)(xb_ld(&bar[XB_XGEN(b.x)]) - nx * (gen + 1u)) < 0, bar);
            asm volatile("s_waitcnt vmcnt(0)" ::: "memory");
        } else {
            asm volatile("buffer_inv sc1" ::: "memory");
            XB_SPIN((int)(xb_ld(&bar[XB_XGEN(b.x)]) - nx * (gen + 1u)) < 0, bar);
            asm volatile("s_waitcnt vmcnt(0)" ::: "memory");
        }
    }
    __syncthreads();
}

namespace pg8 {
constexpr int BM = 256, BK = 64, HALF = 128, HTB = HALF * BK * 2, STAGE_BYTES = 8 * HTB;
__host__ __device__ __forceinline__ int lds_byte(int r, int c) { const int st = (r >> 4) * 2 + (c >> 5), rr = r & 15, cc = c & 31, ob = rr * 64 + cc * 2; return st * 1024 + (ob ^ (((ob >> 9) & 1) << 5)); }
__host__ __device__ __forceinline__ void stage_rc(int b, int& R, int& C) { const int st = b / 1024, sb = b % 1024, swz = sb ^ (((sb >> 9) & 1) << 5); R = (st >> 1) * 16 + swz / 64; C = (st & 1) * 32 + (swz % 64) / 2; }
__host__ __device__ __forceinline__ int perm32(int rho) { const int n = rho >> 4, i = rho & 15; return 8 * (i >> 2) + 4 * n + (i & 3); }
struct Unit { int pm, pn, b0, b1; };
__device__ __forceinline__ void std_halves(Unit& u) { u.b0 = u.pn * 256; u.b1 = u.pn * 256 + 128; }

__device__ __forceinline__ const char* sptr(const char* p) { const unsigned long long v = (unsigned long long)p;
    const unsigned lo = (unsigned)__builtin_amdgcn_readfirstlane((int)(unsigned)v), hi = (unsigned)__builtin_amdgcn_readfirstlane((int)(unsigned)(v >> 32));
    return (const char*)(((unsigned long long)hi << 32) | lo); }
struct NoHook { static constexpr bool ON = false; __device__ __forceinline__ void operator()(f32x4 (&)[2][2][4][2], const Unit&, int, int, int, int) const {} };
typedef int i32x8 __attribute__((ext_vector_type(8)));
typedef int i32x4 __attribute__((ext_vector_type(4)));
__device__ __forceinline__ void mma8(f32x4& c, const bf16x8& a0, const bf16x8& a1, const bf16x8& b0, const bf16x8& b1) {
    const i32x4 x0 = __builtin_bit_cast(i32x4, a0), x1 = __builtin_bit_cast(i32x4, a1), y0 = __builtin_bit_cast(i32x4, b0), y1 = __builtin_bit_cast(i32x4, b1);
    const i32x8 X = {x0[0], x0[1], x0[2], x0[3], x1[0], x1[1], x1[2], x1[3]}, Y = {y0[0], y0[1], y0[2], y0[3], y1[0], y1[1], y1[2], y1[3]};
    asm volatile("v_mfma_f32_16x16x128_f8f6f4 %0, %1, %2, %0" : "+v"(c) : "v"(X), "v"(Y));
}
__device__ __forceinline__ void mma8z(f32x4& c, const bf16x8& a0, const bf16x8& a1, const bf16x8& b0, const bf16x8& b1) {
    const i32x4 x0 = __builtin_bit_cast(i32x4, a0), x1 = __builtin_bit_cast(i32x4, a1), y0 = __builtin_bit_cast(i32x4, b0), y1 = __builtin_bit_cast(i32x4, b1);
    const i32x8 X = {x0[0], x0[1], x0[2], x0[3], x1[0], x1[1], x1[2], x1[3]}, Y = {y0[0], y0[1], y0[2], y0[3], y1[0], y1[1], y1[2], y1[3]};
    asm volatile("v_mfma_f32_16x16x128_f8f6f4 %0, %1, %2, 0" : "=&v"(c) : "v"(X), "v"(Y));
}
template <class Epi, class Sched, bool GATHER, class Hook = NoHook, bool F8 = false>
__device__ __forceinline__ void gemm_phase(LAS unsigned char* lds, const bf16_t* A, const int lda, const bf16_t* Bt, const int K, const int* rowmap, const Sched& S, const Epi& E, const Hook& HK = Hook()) {
    int tid_ = threadIdx.x; asm volatile("" : "+v"(tid_));
    const int tid = tid_, wid = __builtin_amdgcn_readfirstlane(tid >> 6), lane = tid & 63, wr = wid >> 2, wc = wid & 3, fr = lane & 15, fq = lane >> 4;
    const int nt = K / BK;
    const unsigned rowB = (unsigned)lda * 2u;
    unsigned CA2, voffB, voffA; int vRM;
    { int R, C; stage_rc(tid * 16, R, C); const int Rb = Epi::PERM ? ((R & ~31) + perm32(R & 31)) : R;
        CA2 = (unsigned)C * 2u; voffB = (unsigned)(Rb * K + C) * 2u; voffA = (unsigned)R * rowB + (unsigned)C * 2u; vRM = RM_OFF + R * 4; }
    const size_t kstep = (size_t)(BK * 2);
    const size_t rowK = (size_t)K * 2;
    const size_t halfA = (size_t)HALF * rowB, d64A = (size_t)64 * rowB, d64B = (size_t)64 * rowK;
    const unsigned ldsw = (unsigned)wid * 1024u;
    const int aoff = lds_byte(wr * 64 + fr, fq * 8), boff = lds_byte(wc * 32 + fr, fq * 8);
#define PG8_SA(b, h) (((b) * 2 + (h)) * HTB)
#define PG8_SB(b, h) ((4 + (b) * 2 + (h)) * HTB)
#define PG8_DMA(bufoff, i, ptr) __builtin_amdgcn_global_load_lds((const unsigned*)(ptr), (LAS unsigned*)(lds + (bufoff) + ldsw + (i) * 8192), 16, 0, 0)
#define PG8_STAGE(bufoff, gbase, voff, delta) do { const char* _g0 = sptr((const char*)(gbase)); const char* _g1 = sptr((const char*)(gbase) + (delta)); \
        unsigned _o = (voff); asm volatile("" : "+v"(_o)); PG8_DMA(bufoff, 0, _g0 + _o); PG8_DMA(bufoff, 1, _g1 + _o); } while (0)
#define PG8_STAGE_G(bufoff, gbase, offs) do { const char* _g = sptr((const char*)(gbase)); _Pragma("unroll") for (int _i = 0; _i < 2; ++_i) { \
        unsigned _o = (offs)[_i]; asm volatile("" : "+v"(_o)); PG8_DMA(bufoff, _i, _g + _o); } } while (0)
#define PG8_STAGE_B(bufoff, gbase) PG8_STAGE(bufoff, gbase, voffB, d64B)
#define PG8_RMGET(dst, h, nu) do { if constexpr (GATHER) { const int _ro = ((nu) ? (rmbuf ^ 1) : rmbuf) * 1024 + (h) * 512; \
        _Pragma("unroll") for (int _i = 0; _i < 2; ++_i) dst[_i] = *(const LAS unsigned*)(lds + vRM + _ro + _i * 256) * rowB + CA2; } } while (0)
#define PG8_STAGE_A(bufoff, kb, h, nu, offs) do { if constexpr (GATHER) PG8_STAGE_G(bufoff, (const char*)A + (kb), offs); \
        else PG8_STAGE(bufoff, ((nu) ? nAu : cAu) + (size_t)(h) * halfA + (kb), voffA, d64A); } while (0)
#define PG8_LDA(dst, b, h) do { _Pragma("unroll") for (int m = 0; m < 4; ++m) _Pragma("unroll") for (int k = 0; k < 2; ++k) dst[m][k] = *(const LAS bf16x8*)(lds + PG8_SA(b, h) + aoff + m * 2048 + k * 1024); } while (0)
#define PG8_LDB(dst, b, h) do { _Pragma("unroll") for (int n = 0; n < 2; ++n) _Pragma("unroll") for (int k = 0; k < 2; ++k) dst[n][k] = *(const LAS bf16x8*)(lds + PG8_SB(b, h) + boff + n * 2048 + k * 1024); } while (0)
#define PG8_MMA(ai, bj, At, Bt_) do { __builtin_amdgcn_s_setprio(1); _Pragma("unroll") for (int m = 0; m < 4; ++m) _Pragma("unroll") for (int n = 0; n < 2; ++n) { \
        if constexpr (F8) mma8(acc[ai][bj][m][n], Bt_[n][0], Bt_[n][1], At[m][0], At[m][1]); \
        else { _Pragma("unroll") for (int k = 0; k < 2; ++k) acc[ai][bj][m][n] = __builtin_amdgcn_mfma_f32_16x16x32_bf16(Bt_[n][k], At[m][k], acc[ai][bj][m][n], 0, 0, 0); } } \
        __builtin_amdgcn_s_setprio(0); } while (0)
#define PG8_MMA0(ai, bj, At, Bt_) do { __builtin_amdgcn_s_setprio(1); _Pragma("unroll") for (int m = 0; m < 4; ++m) _Pragma("unroll") for (int n = 0; n < 2; ++n) { \
        if constexpr (F8) mma8z(acc[ai][bj][m][n], Bt_[n][0], Bt_[n][1], At[m][0], At[m][1]); \
        else { acc[ai][bj][m][n] = __builtin_amdgcn_mfma_f32_16x16x32_bf16(Bt_[n][0], At[m][0], (f32x4){0.f, 0.f, 0.f, 0.f}, 0, 0, 0); \
               acc[ai][bj][m][n] = __builtin_amdgcn_mfma_f32_16x16x32_bf16(Bt_[n][1], At[m][1], acc[ai][bj][m][n], 0, 0, 0); } } \
        __builtin_amdgcn_s_setprio(0); } while (0)
#define PG8_WAIT_V(n) asm volatile("s_waitcnt vmcnt(" #n ")" ::: "memory")
#define PG8_WAIT_L(n) asm volatile("s_waitcnt lgkmcnt(" #n ")" ::: "memory")
#define PG8_BAR __builtin_amdgcn_s_barrier()
#define PG8_SCHED __builtin_amdgcn_sched_barrier(0)
    Unit cur, nxt; int ui = 0;
    if (!S.next(0, cur)) return;
    int rmbuf = 0;
    if constexpr (GATHER) {
        if (wid < 4) { unsigned _o = (unsigned)tid * 4u; asm volatile("" : "+v"(_o)); __builtin_amdgcn_global_load_lds((const unsigned*)(sptr((const char*)(rowmap + cur.pm * BM)) + _o), (LAS unsigned*)(lds + RM_OFF + wid * 256), 4, 0, 0); }
        PG8_WAIT_V(0); __syncthreads();
    }
    f32x4 acc[2][2][4][2];
    bf16x8 At[4][2], B0[2][2], B1[2][2];
    const char* cAu = (const char*)A + (GATHER ? (size_t)0 : (size_t)(cur.pm * BM) * rowB); const char* nAu = cAu;
    const char* cB0 = (const char*)Bt + (size_t)cur.b0 * rowK; const char* cB1 = (const char*)Bt + (size_t)cur.b1 * rowK;
    unsigned ro[2] = {0u, 0u}, ro1[2] = {0u, 0u};
    PG8_RMGET(ro, 0, false); PG8_RMGET(ro1, 1, false);
    PG8_STAGE_B(PG8_SB(0, 0), cB0); PG8_STAGE_B(PG8_SB(0, 1), cB1); PG8_STAGE_A(PG8_SA(0, 0), (size_t)0, 0, false, ro); PG8_STAGE_A(PG8_SA(0, 1), (size_t)0, 1, false, ro1);
    if (wr == 1) PG8_BAR;
    PG8_WAIT_V(2); PG8_BAR;
    PG8_STAGE_B(PG8_SB(1, 0), cB0 + kstep); PG8_STAGE_A(PG8_SA(1, 0), kstep, 0, false, ro); PG8_STAGE_B(PG8_SB(1, 1), cB1 + kstep);
    PG8_WAIT_V(6); PG8_BAR;
    for (;;) {
        const bool has_next = S.next(ui + 1, nxt);
        const char* nB0 = has_next ? (const char*)Bt + (size_t)nxt.b0 * rowK : cB0; const char* nB1 = has_next ? (const char*)Bt + (size_t)nxt.b1 * rowK : cB1;
        if constexpr (GATHER) {
            if (has_next && wid < 4) { unsigned _o = (unsigned)tid * 4u; asm volatile("" : "+v"(_o)); __builtin_amdgcn_global_load_lds((const unsigned*)(sptr((const char*)(rowmap + nxt.pm * BM)) + _o), (LAS unsigned*)(lds + RM_OFF + (rmbuf ^ 1) * 1024 + wid * 256), 4, 0, 0); }
        } else nAu = has_next ? (const char*)A + (size_t)(nxt.pm * BM) * rowB : cAu;
#define PG8_TRIP(T_, MM) do { const int t = (T_); \
            const bool last = (t == nt - 2), nu = last && has_next; \
            if constexpr (Hook::ON) { if (t == nt / 2) HK(acc, cur, wr, wc, fr, fq); } \
            const size_t k1 = (size_t)(t + 1) * kstep, k2 = last ? (size_t)0 : (size_t)(t + 2) * kstep, k3 = k2 + kstep; \
            const char* b20 = last ? nB0 : cB0 + k2; const char* b21 = last ? nB1 : cB1 + k2; \
            const char* b30 = b20 + kstep; const char* b31 = b21 + kstep; \
            PG8_RMGET(ro, 1, false); PG8_LDB(B0, 0, 0); PG8_LDB(B1, 0, 1); PG8_SCHED; PG8_LDA(At, 0, 0); PG8_STAGE_A(PG8_SA(1, 1), k1, 1, false, ro); \
            PG8_WAIT_V(8); PG8_WAIT_L(0); PG8_BAR; MM(0, 0, At, B0); MM(0, 1, At, B1); PG8_BAR; PG8_SCHED; \
            PG8_RMGET(ro, 0, nu); PG8_LDA(At, 0, 1); PG8_STAGE_B(PG8_SB(0, 0), b20); PG8_STAGE_B(PG8_SB(0, 1), b21); PG8_STAGE_A(PG8_SA(0, 0), k2, 0, last, ro); \
            PG8_WAIT_V(8); PG8_WAIT_L(0); PG8_BAR; MM(1, 0, At, B0); MM(1, 1, At, B1); PG8_BAR; PG8_SCHED; \
            PG8_RMGET(ro, 1, nu); PG8_LDB(B0, 1, 0); PG8_LDB(B1, 1, 1); PG8_SCHED; PG8_LDA(At, 1, 0); PG8_STAGE_A(PG8_SA(0, 1), k2, 1, last, ro); \
            PG8_WAIT_V(8); PG8_WAIT_L(0); PG8_BAR; PG8_MMA(0, 0, At, B0); PG8_MMA(0, 1, At, B1); PG8_BAR; PG8_SCHED; \
            PG8_RMGET(ro, 0, nu); PG8_LDA(At, 1, 1); PG8_STAGE_B(PG8_SB(1, 0), b30); PG8_STAGE_B(PG8_SB(1, 1), b31); PG8_STAGE_A(PG8_SA(1, 0), k3, 0, last, ro); \
            PG8_WAIT_V(8); PG8_WAIT_L(0); PG8_BAR; PG8_MMA(1, 0, At, B0); PG8_MMA(1, 1, At, B1); PG8_BAR; PG8_SCHED; \
        } while (0)
        PG8_TRIP(0, PG8_MMA0);
#pragma unroll 1
        for (int tt = 2; tt < nt; tt += 2) PG8_TRIP(tt, PG8_MMA);
#undef PG8_TRIP
        if (wr == 0) PG8_BAR;
        if constexpr (F8) asm volatile("s_nop 7\n\ts_nop 7\n\ts_nop 7" ::: "memory");
        E(acc, cur, wr, wc, fr, fq);
        if (!has_next) break;
        cur = nxt; cB0 = nB0; cB1 = nB1; cAu = nAu; ++ui; rmbuf ^= 1;
        if (wr == 1) PG8_BAR;
    }
    PG8_WAIT_V(0);
    PG8_BAR;
#undef PG8_SA
#undef PG8_SB
#undef PG8_STAGE
#undef PG8_DMA
#undef PG8_STAGE_G
#undef PG8_STAGE_B
#undef PG8_RMGET
#undef PG8_STAGE_A
#undef PG8_LDA
#undef PG8_LDB
#undef PG8_MMA
#undef PG8_MMA0
#undef PG8_WAIT_V
#undef PG8_WAIT_L
#undef PG8_BAR
#undef PG8_SCHED
}
}

enum { I_X = 0, I_C, I_CTX, I_CCTX, I_ADAW, I_ADAB, I_NMIX, I_NFFN, I_WIN, I_LBL, I_HNW, I_SNW, I_SGUW, I_SGUB, I_WBA, I_WBB, I_WOUT, I_RW, I_EWG, I_EWU, I_EWD, I_FNW, N_IN };
struct Args { const float* in[N_IN]; float* out; unsigned char* ws; int ph_lo, ph_hi; };
struct InTab { __device__ __forceinline__ const float* operator[](int i) const {
    typedef const float* __attribute__((address_space(4))) const* kptr_t;
    return ((kptr_t)__builtin_amdgcn_kernarg_segment_ptr())[i]; } };
struct Frame {
    LAS unsigned char* lds;
    int tid, lane, wave, G, bid, vcu;
    InTab in;
    float* out; unsigned char* ws;
};
using pg8::Unit;

struct StaticOrder {
    int nM, nN, nwg, G, c;
    __device__ __forceinline__ void init(int nM_, int nN_, int G_, int c_) { nM = nM_; nN = nN_; nwg = nM * nN; G = G_; c = c_; }
    __device__ __forceinline__ bool decode(int L, Unit& u) const {
        int wgid = L; { const int q = nwg / 8, r = nwg % 8, xcd = wgid % 8, off = wgid / 8; wgid = (xcd < r ? xcd * (q + 1) : r * (q + 1) + (xcd - r) * q) + off; }
        const int nig = 8 * nN, gid = wgid / nig, fm = gid * 8, gsz = (nM - fm) < 8 ? (nM - fm) : 8;
        u.pm = fm + ((wgid % nig) % gsz); u.pn = (wgid % nig) / gsz; pg8::std_halves(u); return true;
    }
    __device__ __forceinline__ bool next(int i, Unit& u) const { const long L = (long)i * G + c; if (L >= nwg) return false; return decode((int)L, u); }
};
struct SchedIn {
    int G, c, nct;
    __device__ __forceinline__ void init(int G_, int c_, int nct_) { G = G_; c = c_; nct = nct_; }
    __device__ __forceinline__ bool next(int i, Unit& u) const {
        const int L = i * G + c; if (L >= 128 * nct) return false;
        constexpr int GR = SCHED_GR;
        const int xcd = L & 7, off = L >> 3;
        const int grp = off / (GR * nct), rem = off % (GR * nct);
        u.pm = xcd * 16 + grp * GR + rem % GR; u.pn = (rem / GR + 3 * xcd) % nct; pg8::std_halves(u); return true;
    }
};
struct SchedCtx {
    int b, h, dir;
    __device__ __forceinline__ bool next(int i, Unit& u) const { if (i > 0) return false; u.pm = 128 + b; u.pn = dir * 4 + h; u.b0 = 512 + dir * 512 + h * 128; u.b1 = 1536 + h * 128; return true; }
};
struct SchedMoe1 {
    int G, c;
    __device__ __forceinline__ bool next(int i, Unit& u) const {
        const int L = i * G + c; if (L >= 4096) return false;
        const int e = L >> 8, r = L & 255, xcd = r >> 5, j = r & 31;
        const int rt16 = (xcd >> 1) * 4 + (j >> 3), ct = (xcd & 1) * 8 + (j & 7), b = rt16 >> 2, rt = rt16 & 3;
        u.pm = (b * NE + e) * 4 + rt; u.pn = e * 16 + ct; pg8::std_halves(u); return true;
    }
};
struct SchedMoe2 {
    int G, c;
    __device__ __forceinline__ bool next(int i, Unit& u) const {
        const int L = i * G + c; if (L >= 1024) return false;
        const int e = L >> 6, r = L & 63, rt16 = r >> 2, ct = r & 3, b = rt16 >> 2, rt = rt16 & 3;
        u.pm = (b * NE + e) * 4 + rt; u.pn = e * 4 + ct; pg8::std_halves(u); return true;
    }
};

enum { ACT_NONE = 0, ACT_SILU, ACT_LOGF, ACT_GELU, ACT_SIGM };
template <int MODE> __device__ __forceinline__ float act1(float v, float lb) {
    if (MODE == ACT_SILU) return siluf(v);
    if (MODE == ACT_GELU) return geluf(v);
    if (MODE == ACT_SIGM) return sigm(v);
    if (MODE == ACT_LOGF) return __logf(lb + (1.f - lb) * sigm(v));
    return v;
}
template <int MODE> __device__ __forceinline__ f32x2 act2(f32x2 v, f32x2 lb, f32x2 omlb) {
    constexpr float NL2E = -1.4426950408889634f, GC = 1.5957691216057308f;
    if (MODE == ACT_NONE) return v;
    f32x2 x;
    if (MODE == ACT_GELU) x = v * ((v * v) * (f32x2){0.044715f * GC * NL2E, 0.044715f * GC * NL2E} + (f32x2){GC * NL2E, GC * NL2E});
    else x = v * (f32x2){NL2E, NL2E};
    const f32x2 d = (f32x2){__builtin_amdgcn_exp2f(x[0]), __builtin_amdgcn_exp2f(x[1])} + (f32x2){1.f, 1.f};
    const f32x2 sg = {__builtin_amdgcn_rcpf(d[0]), __builtin_amdgcn_rcpf(d[1])};
    if (MODE == ACT_SIGM) return sg;
    if (MODE == ACT_LOGF) { const f32x2 f = omlb * sg + lb; return (f32x2){__builtin_amdgcn_logf(f[0]), __builtin_amdgcn_logf(f[1])} * (f32x2){0.6931471805599453f, 0.6931471805599453f}; }
    return v * sg;
}
template <int MODE> __device__ __forceinline__ void epi_store_act(const f32x4 (&acc)[2][2][4][2], bf16_t* base, int ld, int row0, int col0, const float* lbp) {
    f32x2 lbv[2][4], oml[2][4];
#pragma unroll
    for (int bj = 0; bj < 2; ++bj)
#pragma unroll
        for (int j = 0; j < 4; ++j) { lbv[bj][j] = (MODE == ACT_LOGF) ? (f32x2){lbp[col0 + bj * 128 + 2 * j], lbp[col0 + bj * 128 + 2 * j + 1]} : (f32x2){0.f, 0.f}; oml[bj][j] = (f32x2){1.f, 1.f} - lbv[bj][j]; }
#pragma unroll
    for (int ai = 0; ai < 2; ++ai)
#pragma unroll
        for (int m = 0; m < 4; ++m) { unsigned ro = (unsigned)((row0 + ai * 128 + m * 16) * ld + col0) * 2u; asm volatile("" : "+v"(ro));
            bf16_t* rowp = (bf16_t*)((unsigned char*)base + ro);
#pragma unroll
            for (int bj = 0; bj < 2; ++bj) { const f32x4 v0 = acc[ai][bj][m][0], v1 = acc[ai][bj][m][1];
                const f32x2 r0 = act2<MODE>((f32x2){v0[0], v0[1]}, lbv[bj][0], oml[bj][0]), r1 = act2<MODE>((f32x2){v0[2], v0[3]}, lbv[bj][1], oml[bj][1]);
                const f32x2 r2 = act2<MODE>((f32x2){v1[0], v1[1]}, lbv[bj][2], oml[bj][2]), r3 = act2<MODE>((f32x2){v1[2], v1[3]}, lbv[bj][3], oml[bj][3]);
                u32x4 w; w.x = cvt_pk_bf16(r0[0], r0[1]); w.y = cvt_pk_bf16(r1[0], r1[1]); w.z = cvt_pk_bf16(r2[0], r2[1]); w.w = cvt_pk_bf16(r3[0], r3[1]);
                *(u32x4*)(rowp + bj * 128) = w; } }
}
struct EpiIn {
    static constexpr bool PERM = true;
    unsigned char* ws;
    __device__ __forceinline__ void operator()(const f32x4 (&acc)[2][2][4][2], const Unit& u, int wr, int wc, int fr, int fq) const {
        const int pn = u.pn; const int row0 = u.pm * 256 + wr * 64 + fr; const int cw = wc * 32 + 8 * fq;
        const float* lb = (const float*)(ws + WS_LB);
        if (pn < 2)       epi_store_act<ACT_SILU>(acc, (bf16_t*)(ws + WS_Q), 512, row0, pn * 256 + cw, nullptr);
        else if (pn < 4)  epi_store_act<ACT_LOGF>(acc, (bf16_t*)(ws + WS_FF), 512, row0, (pn - 2) * 256 + cw, lb);
        else if (pn < 6)  epi_store_act<ACT_LOGF>(acc, (bf16_t*)(ws + WS_FB), 512, row0, (pn - 4) * 256 + cw, lb + 512);
        else if (pn < 8)  epi_store_act<ACT_NONE>(acc, (bf16_t*)(ws + WS_V), 512, row0, (pn - 6) * 256 + cw, nullptr);
        else if (pn < 10) epi_store_act<ACT_SILU>(acc, (bf16_t*)(ws + WS_G), 512, row0, (pn - 8) * 256 + cw, nullptr);
        else if (pn < 12) epi_store_act<ACT_GELU>(acc, (bf16_t*)(ws + WS_U), 512, row0, (pn - 10) * 256 + cw, nullptr);
        else              epi_store_act<ACT_GELU>(acc, (bf16_t*)(ws + WS_VS), 512, row0, (pn - 12) * 256 + cw, nullptr);
    }
};
struct EpiGab {
    static constexpr bool PERM = true;
    unsigned char* ws;
    __device__ __forceinline__ void operator()(const f32x4 (&acc)[2][2][4][2], const Unit& u, int wr, int wc, int fr, int fq) const {
        const int row0 = u.pm * 256 + wr * 64 + fr, col0 = u.pn * 128 + wc * 32 + 8 * fq;
        constexpr float KE = -1.4426950408889634f / (SC_H8 * SC_W8);
#pragma unroll
        for (int ai = 0; ai < 2; ++ai)
#pragma unroll
            for (int m = 0; m < 4; ++m) { unsigned ro = (unsigned)((row0 + ai * 128 + m * 16) * 1024 + col0) * 2u; asm volatile("" : "+v"(ro));
                float rr[8], sb[8];
#pragma unroll
                for (int p = 0; p < 4; ++p) {
                    const f32x2 xa = (f32x2){acc[ai][0][m][p >> 1][2 * (p & 1)], acc[ai][0][m][p >> 1][2 * (p & 1) + 1]} * (f32x2){KE, KE}, xb = (f32x2){acc[ai][1][m][p >> 1][2 * (p & 1)], acc[ai][1][m][p >> 1][2 * (p & 1) + 1]} * (f32x2){KE, KE};
                    const f32x2 da = (f32x2){__builtin_amdgcn_exp2f(xa[0]), __builtin_amdgcn_exp2f(xa[1])} + (f32x2){1.f, 1.f}, db = (f32x2){__builtin_amdgcn_exp2f(xb[0]), __builtin_amdgcn_exp2f(xb[1])} + (f32x2){1.f, 1.f};
                    const f32x2 r2 = db * (f32x2){__builtin_amdgcn_rcpf(da[0]), __builtin_amdgcn_rcpf(da[1])};
                    sb[2 * p] = db[0]; sb[2 * p + 1] = db[1]; rr[2 * p] = r2[0]; rr[2 * p + 1] = r2[1]; }
                u32x4 w; w.x = cvt_pk_bf16(rr[0], rr[1]); w.y = cvt_pk_bf16(rr[2], rr[3]); w.z = cvt_pk_bf16(rr[4], rr[5]); w.w = cvt_pk_bf16(rr[6], rr[7]);
                *(u32x4*)(ws + WS_GA + ro) = w;
                w.x = cvt_pk_bf16(sb[0], sb[1]); w.y = cvt_pk_bf16(sb[2], sb[3]); w.z = cvt_pk_bf16(sb[4], sb[5]); w.w = cvt_pk_bf16(sb[6], sb[7]);
                *(u32x4*)(ws + WS_GB + ro) = w; }
    }
};
struct SchedGab {
    SchedIn s;
    __device__ __forceinline__ bool next(int i, Unit& u) const { if (!s.next(i, u)) return false; u.b0 = u.pn * 128; u.b1 = 1024 + u.pn * 128; return true; }
};
struct EpiCtx {
    static constexpr bool PERM = true;
    unsigned char* ws;
    __device__ __forceinline__ void operator()(const f32x4 (&acc)[2][2][4][2], const Unit& u, int wr, int wc, int fr, int fq) const {
        const int dir = u.pn >> 2, h = u.pn & 3; const int row0 = u.pm * 256 + wr * 64 + fr, col0 = h * 128 + wc * 32 + 8 * fq;
        const float* lb = (const float*)(ws + WS_LB) + dir * 512;
        bf16_t* FO = (bf16_t*)(ws + (dir ? WS_FB : WS_FF)); bf16_t* VO = (bf16_t*)(ws + WS_V);
        float lbv[8];
#pragma unroll
        for (int j = 0; j < 8; ++j) lbv[j] = lb[col0 + j];
#pragma unroll
        for (int ai = 0; ai < 2; ++ai)
#pragma unroll
            for (int m = 0; m < 4; ++m) { const size_t ro = (size_t)(row0 + ai * 128 + m * 16) * 512 + col0;
                { const f32x4 v0 = acc[ai][0][m][0], v1 = acc[ai][0][m][1]; u32x4 w;
                  w.x = cvt_pk_bf16(act1<ACT_LOGF>(v0[0], lbv[0]), act1<ACT_LOGF>(v0[1], lbv[1])); w.y = cvt_pk_bf16(act1<ACT_LOGF>(v0[2], lbv[2]), act1<ACT_LOGF>(v0[3], lbv[3]));
                  w.z = cvt_pk_bf16(act1<ACT_LOGF>(v1[0], lbv[4]), act1<ACT_LOGF>(v1[1], lbv[5])); w.w = cvt_pk_bf16(act1<ACT_LOGF>(v1[2], lbv[6]), act1<ACT_LOGF>(v1[3], lbv[7]));
                  *(u32x4*)(FO + ro) = w; }
                { const f32x4 v0 = acc[ai][1][m][0] + 0.f, v1 = acc[ai][1][m][1] + 0.f; u32x4 w;
                  w.x = cvt_pk_bf16(v0[0], v0[1]); w.y = cvt_pk_bf16(v0[2], v0[3]); w.z = cvt_pk_bf16(v1[0], v1[1]); w.w = cvt_pk_bf16(v1[2], v1[3]);
                  *(u32x4*)(VO + ro) = w; } }
    }
};
template <bool ADD> struct EpiGate {
    static constexpr bool PERM = true;
    const bf16_t* gate; const bf16_t* prev; bf16_t* out;
    __device__ __forceinline__ void operator()(const f32x4 (&acc)[2][2][4][2], const Unit& u, int wr, int wc, int fr, int fq) const {
        const int row0 = u.pm * 256 + wr * 64 + fr, col0 = u.pn * 256 + wc * 32 + 8 * fq;
        u32x4 gq[2][4][2];
#pragma unroll
        for (int ai = 0; ai < 2; ++ai)
#pragma unroll
            for (int m = 0; m < 4; ++m)
#pragma unroll
                for (int bj = 0; bj < 2; ++bj) gq[ai][m][bj] = *(const u32x4*)(gate + (size_t)(row0 + ai * 128 + m * 16) * 1024 + col0 + bj * 128);
#pragma unroll
        for (int ai = 0; ai < 2; ++ai)
#pragma unroll
            for (int m = 0; m < 4; ++m) { const size_t ro = (size_t)(row0 + ai * 128 + m * 16) * 1024 + col0;
#pragma unroll
                for (int bj = 0; bj < 2; ++bj) { const f32x4 v0 = acc[ai][bj][m][0], v1 = acc[ai][bj][m][1];
                    const u32x4 g = gq[ai][m][bj];
                    float r[8] = {v0[0] * __builtin_amdgcn_rcpf(bflo(g.x)), v0[1] * __builtin_amdgcn_rcpf(bfhi(g.x)), v0[2] * __builtin_amdgcn_rcpf(bflo(g.y)), v0[3] * __builtin_amdgcn_rcpf(bfhi(g.y)),
                                  v1[0] * __builtin_amdgcn_rcpf(bflo(g.z)), v1[1] * __builtin_amdgcn_rcpf(bfhi(g.z)), v1[2] * __builtin_amdgcn_rcpf(bflo(g.w)), v1[3] * __builtin_amdgcn_rcpf(bfhi(g.w))};
                    if (ADD) { const u32x4 p = *(const u32x4*)(prev + ro + bj * 128);
                        r[0] += bflo(p.x); r[1] += bfhi(p.x); r[2] += bflo(p.y); r[3] += bfhi(p.y); r[4] += bflo(p.z); r[5] += bfhi(p.z); r[6] += bflo(p.w); r[7] += bfhi(p.w); }
                    u32x4 w; w.x = cvt_pk_bf16(r[0], r[1]); w.y = cvt_pk_bf16(r[2], r[3]); w.z = cvt_pk_bf16(r[4], r[5]); w.w = cvt_pk_bf16(r[6], r[7]);
                    *(u32x4*)(out + ro + bj * 128) = w; } }
    }
};
struct HookRatio {
    static constexpr bool ON = true;
    const bf16_t* ratio;
    __device__ __forceinline__ void operator()(f32x4 (&acc)[2][2][4][2], const Unit& u, int wr, int wc, int fr, int fq) const {
        int row0 = u.pm * 256 + wr * 64 + fr, col0 = u.pn * 256 + wc * 32 + 8 * fq;
        asm volatile("" : "+v"(row0), "+v"(col0));
#pragma unroll
        for (int ai = 0; ai < 2; ++ai)
#pragma unroll
            for (int m = 0; m < 4; ++m) { const size_t ro = (size_t)(row0 + ai * 128 + m * 16) * 1024 + col0;
#pragma unroll
                for (int bj = 0; bj < 2; ++bj) { const u32x4 a = __builtin_nontemporal_load((const u32x4*)(ratio + ro + bj * 128));
                    const unsigned aw[4] = {a.x, a.y, a.z, a.w};
#pragma unroll
                    for (int e = 0; e < 4; ++e) { acc[ai][bj][m][e >> 1][2 * (e & 1)] *= bflo(aw[e]); acc[ai][bj][m][e >> 1][2 * (e & 1) + 1] *= bfhi(aw[e]); } }
                asm volatile("" ::: "memory"); }
    }
};
struct EpiX1 {
    static constexpr bool PERM = true;
    const float* x; const float* mod; bf16_t* out;
    __device__ __forceinline__ void operator()(const f32x4 (&acc)[2][2][4][2], const Unit& u, int wr, int wc, int fr, int fq) const {
        const int row0 = u.pm * 256 + wr * 64 + fr, col0 = u.pn * 256 + wc * 32 + 8 * fq;
        const float* gm = mod + (size_t)(u.pm >> 5) * (NMOD * D) + 2 * D;
        f32x4 gv[2][2];
#pragma unroll
        for (int bj = 0; bj < 2; ++bj)
#pragma unroll
            for (int n = 0; n < 2; ++n) gv[bj][n] = *(const f32x4*)(gm + col0 + bj * 128 + 4 * n);
        constexpr int X1_AHEAD = 3;
        f32x4 xg[X1_AHEAD + 1][2][2];
#define X1_LOAD(i_) { const size_t rw_ = (size_t)(row0 + ((i_) >> 2) * 128 + ((i_) & 3) * 16); \
            _Pragma("unroll") for (int bj = 0; bj < 2; ++bj) { const float* xp = x + rw_ * D + col0 + bj * 128; \
                xg[(i_) % (X1_AHEAD + 1)][bj][0] = __builtin_nontemporal_load((const f32x4*)xp); xg[(i_) % (X1_AHEAD + 1)][bj][1] = __builtin_nontemporal_load((const f32x4*)(xp + 4)); } }
#pragma unroll
        for (int i = 0; i < X1_AHEAD; ++i) X1_LOAD(i)
#pragma unroll
        for (int i = 0; i < 8; ++i) { const int ai = i >> 2, m = i & 3; const size_t row = (size_t)(row0 + ai * 128 + m * 16);
            if (i + X1_AHEAD < 8) X1_LOAD(i + X1_AHEAD)
#pragma unroll
            for (int bj = 0; bj < 2; ++bj) {
                const f32x4 v0 = xg[i % (X1_AHEAD + 1)][bj][0] + gv[bj][0] * acc[ai][bj][m][0], v1 = xg[i % (X1_AHEAD + 1)][bj][1] + gv[bj][1] * acc[ai][bj][m][1];
                u32x4 w; w.x = cvt_pk_bf16(v0[0], v0[1]); w.y = cvt_pk_bf16(v0[2], v0[3]); w.z = cvt_pk_bf16(v1[0], v1[1]); w.w = cvt_pk_bf16(v1[2], v1[3]);
                *(u32x4*)(out + row * (2 * D) + col0 + bj * 128) = w; } }
#undef X1_LOAD
    }
};
struct EpiHid {
    static constexpr bool PERM = true;
    unsigned char* hid;
    __device__ __forceinline__ void operator()(const f32x4 (&acc)[2][2][4][2], const Unit& u, int wr, int wc, int fr, int fq) const {
        const int row0 = u.pm * 256 + wr * 64 + fr, col0 = (u.pn & 15) * 128 + wc * 32 + 8 * fq;
#pragma unroll
        for (int ai = 0; ai < 2; ++ai)
#pragma unroll
            for (int m = 0; m < 4; ++m) { const f32x4 g0 = acc[ai][0][m][0], g1 = acc[ai][0][m][1], u0 = acc[ai][1][m][0], u1 = acc[ai][1][m][1];
                constexpr float SI = 1.f / (SC_H8 * SC_W8), SO = SC_HID8 / (SC_H8 * SC_W8), KE = -SI * 1.4426950408889634f, KM = SI * SO;
                float hv[8];
#pragma unroll
                for (int p = 0; p < 4; ++p) {
                    const f32x2 g = p < 2 ? (f32x2){g0[2 * p], g0[2 * p + 1]} : (f32x2){g1[2 * p - 4], g1[2 * p - 3]}, u = p < 2 ? (f32x2){u0[2 * p], u0[2 * p + 1]} : (f32x2){u1[2 * p - 4], u1[2 * p - 3]};
                    const f32x2 x = g * (f32x2){KE, KE}, gu = (g * u) * (f32x2){KM, KM};
                    const f32x2 d = (f32x2){__builtin_amdgcn_exp2f(x[0]), __builtin_amdgcn_exp2f(x[1])} + (f32x2){1.f, 1.f};
                    const f32x2 h = gu * (f32x2){__builtin_amdgcn_rcpf(d[0]), __builtin_amdgcn_rcpf(d[1])};
                    hv[2 * p] = h[0]; hv[2 * p + 1] = h[1]; }
                u32x2 w; w.x = pk4_f8m(hv[0], hv[1], hv[2], hv[3]); w.y = pk4_f8m(hv[4], hv[5], hv[6], hv[7]);
                unsigned off = (unsigned)(row0 + ai * 128 + m * 16) * FF + col0; asm volatile("" : "+v"(off));
                *(u32x2*)(hid + off) = w; }
    }
};
struct EpiYe {
    static constexpr bool PERM = true;
    const float* gate; unsigned char* ye;
    __device__ __forceinline__ void operator()(const f32x4 (&acc)[2][2][4][2], const Unit& u, int wr, int wc, int fr, int fq) const {
        const int row0 = u.pm * 256 + wr * 64 + fr, col0 = (u.pn & 3) * 256 + wc * 32 + 8 * fq;
        float gtq[2][4];
#pragma unroll
        for (int ai = 0; ai < 2; ++ai)
#pragma unroll
            for (int m = 0; m < 4; ++m) gtq[ai][m] = gate[row0 + ai * 128 + m * 16];
#pragma unroll
        for (int ai = 0; ai < 2; ++ai)
#pragma unroll
            for (int m = 0; m < 4; ++m) { const int row = row0 + ai * 128 + m * 16; const float gt = gtq[ai][m] * (SC_YE8 / (SC_HID8 * SC_W8));
#pragma unroll
                for (int bj = 0; bj < 2; ++bj) { const f32x4 v0 = acc[ai][bj][m][0] * gt, v1 = acc[ai][bj][m][1] * gt;
                    u32x2 w; w.x = pk4_f8(v0[0], v0[1], v0[2], v0[3]); w.y = pk4_f8(v1[0], v1[1], v1[2], v1[3]);
                    unsigned off = (unsigned)row * D + col0 + bj * 128; asm volatile("" : "+v"(off));
                    *(u32x2*)(ye + off) = w; } }
    }
};

constexpr int T64S = 136;
__device__ __forceinline__ void t64_load(f32x4 (&v)[16], const float* src, int ld_src, int lane) {
#pragma unroll
    for (int x = 0; x < 16; ++x) v[x] = __builtin_nontemporal_load((const f32x4*)(src + (size_t)(4 * x + (lane >> 4)) * ld_src + 4 * (lane & 15)));
}
__device__ __forceinline__ void t64_store(const f32x4 (&v)[16], bf16_t* dst, int ld_dst, LAS unsigned char* tile, int lane) {
#pragma unroll
    for (int x = 0; x < 16; ++x) { u32x2 w; w.x = pk2(v[x].x, v[x].y); w.y = pk2(v[x].z, v[x].w); *(LAS u32x2*)(tile + (4 * x + (lane >> 4)) * T64S + 8 * (lane & 15)) = w; }
    LDS_WAIT(); asm volatile("" ::: "memory");
    const int i = lane & 15, grp = lane >> 4, q = i >> 2, p = i & 3;
#pragma unroll
    for (int y = 0; y < 8; ++y) { const int n0 = 16 * (y & 3), kc = grp + 4 * (y >> 2);
        const LAS unsigned char* tp = tile + (8 * kc + q) * T64S + (n0 + 4 * p) * 2;
        typedef short v4i16_t __attribute__((ext_vector_type(4)));
        const v4i16_t lo = __builtin_amdgcn_ds_read_tr16_b64_v4i16((LAS v4i16_t*)tp), hi = __builtin_amdgcn_ds_read_tr16_b64_v4i16((LAS v4i16_t*)(tp + 4 * T64S));
        const bf16x8 o = (bf16x8){lo[0], lo[1], lo[2], lo[3], hi[0], hi[1], hi[2], hi[3]};
        *(GAS bf16x8*)(dst + (size_t)(n0 + i) * ld_dst + 8 * kc) = o; }
    LDS_WAIT(); asm volatile("" ::: "memory");
}
__device__ __forceinline__ void e8_load(f32x4 (&v)[16], const float* src, int ld_src, int lane) {
#pragma unroll
    for (int x = 0; x < 16; ++x) v[x] = __builtin_nontemporal_load((const f32x4*)(src + (size_t)(16 * (lane >> 4) + x) * ld_src + 4 * (lane & 15)));
}
__device__ __forceinline__ void e8_store(const f32x4 (&v)[16], unsigned char* dst, int ld_dst, int lane) {
#pragma unroll
    for (int i = 0; i < 4; ++i) { u32x4 w;
        w.x = pk4_f8(v[0][i] * SC_W8, v[1][i] * SC_W8, v[2][i] * SC_W8, v[3][i] * SC_W8); w.y = pk4_f8(v[4][i] * SC_W8, v[5][i] * SC_W8, v[6][i] * SC_W8, v[7][i] * SC_W8);
        w.z = pk4_f8(v[8][i] * SC_W8, v[9][i] * SC_W8, v[10][i] * SC_W8, v[11][i] * SC_W8); w.w = pk4_f8(v[12][i] * SC_W8, v[13][i] * SC_W8, v[14][i] * SC_W8, v[15][i] * SC_W8);
        *(u32x4*)(dst + (size_t)(4 * (lane & 15) + i) * ld_dst + 16 * (lane >> 4)) = w; }
}
__device__ __forceinline__ void econv_addr(Frame& F, int it, const float*& src, int& ld_src, unsigned char*& dst, int& ld_dst) {
    unsigned char* WGU = F.ws + WS_WGU; unsigned char* WD = F.ws + WS_WD;
    const int which = it >> 13, r = it & 8191, e = r >> 9, q = r & 511;
    if (which < 2) { const int kb = q >> 5, nb = q & 31, n0 = nb * 64; const int drow = (n0 >> 7) * 256 + which * 128 + (n0 & 127);
        src = F.in[which ? I_EWU : I_EWG] + (size_t)e * D * FF + (size_t)(kb * 64) * FF + n0; ld_src = FF; dst = WGU + ((size_t)e * 4096 + drow) * D + kb * 64; ld_dst = D; }
    else { const int kb = q >> 4, nb = q & 15;
        src = F.in[I_EWD] + (size_t)e * FF * D + (size_t)(kb * 64) * D + nb * 64; ld_src = D; dst = WD + ((size_t)e * D + nb * 64) * FF + kb * 64; ld_dst = FF; }
}
__device__ __forceinline__ void econv_drain(Frame& F, unsigned* ctr, int item0, int nitems) {
    constexpr int BATCH = 4;
    for (;;) {
        unsigned base = 0u; if (F.lane == 0) base = atomicAdd(ctr, (unsigned)BATCH);
        base = (unsigned)__builtin_amdgcn_readfirstlane(base);
        if (base >= (unsigned)nitems) break;
        const float* src; int ls; unsigned char* dst; int ld; f32x4 va[16], vb[16];
        econv_addr(F, item0 + (int)base, src, ls, dst, ld); e8_load(va, src, ls, F.lane);
#pragma unroll 1
        for (int j = 0; j < BATCH; j += 2) {
            const float* src2; int ls2; unsigned char* dst2; int ld2; const bool ok2 = (int)base + j + 1 < nitems;
            if (ok2) { econv_addr(F, item0 + (int)base + j + 1, src2, ls2, dst2, ld2); e8_load(vb, src2, ls2, F.lane); }
            e8_store(va, dst, ld, F.lane);
            if (j + 2 < BATCH && (int)base + j + 2 < nitems) { econv_addr(F, item0 + (int)base + j + 2, src, ls, dst, ld); e8_load(va, src, ls, F.lane); }
            if (ok2) e8_store(vb, dst2, ld2, F.lane);
            if ((int)base + j + 2 >= nitems) break;
        }
    }
}
__device__ __forceinline__ void econv_queue(Frame& F) {
    unsigned* ctl = (unsigned*)(F.ws + WS_CTL);
#pragma unroll 1
    for (int qi = 0; qi < 2; ++qi)
        econv_drain(F, ctl + (qi ? CW_QUEUE : CW_QUEUE2), qi ? 0 : 16384 + 7168, qi ? 16384 : 1024);
}

__device__ __forceinline__ void ph_prologue(Frame& F) {
    float* MOD = (float*)(F.ws + WS_MOD);
    if (F.bid < 192) {
        LAS float* sc = (LAS float*)F.lds; LAS float* red = (LAS float*)(F.lds + 20480);
        for (int i = F.tid; i < 5 * D; i += NTHR) { const int r = i >> 10, k = i & 1023; const float cv = (r < 4) ? F.in[I_C][r * D + k] : F.in[I_CCTX][k]; sc[i] = siluf(cv); }
        __syncthreads();
        for (int item = F.bid; item < 192; item += F.G) {
            const int n0 = item * 32, nn = F.tid & 31, kg = F.tid >> 5;
            float a[5] = {0.f, 0.f, 0.f, 0.f, 0.f};
            const float* w = F.in[I_ADAW] + (size_t)(kg * 64) * (NMOD * D) + n0 + nn;
#pragma unroll 8
            for (int kk = 0; kk < 64; ++kk) { const float wv = w[(size_t)kk * (NMOD * D)];
#pragma unroll
                for (int r = 0; r < 5; ++r) a[r] += sc[r * D + kg * 64 + kk] * wv; }
#pragma unroll
            for (int r = 0; r < 5; ++r) red[(kg * 5 + r) * 32 + nn] = a[r];
            __syncthreads();
            if (F.tid < 160) { const int r = F.tid >> 5, n2 = F.tid & 31; float s = F.in[I_ADAB][n0 + n2];
                for (int k2 = 0; k2 < 16; ++k2) s += red[(k2 * 5 + r) * 32 + n2];
                MOD[r * (NMOD * D) + n0 + n2] = s; }
            __syncthreads();
        }
    }
    if (F.bid == F.G - 1) {
        float* LB = (float*)(F.ws + WS_LB);
        for (int i = F.tid; i < 1024; i += NTHR) { const int dir = i >> 9, c = i & 511; const float l0 = F.in[I_LBL][dir * 1024 + c], l1 = F.in[I_LBL][dir * 1024 + 512 + c]; LB[i] = 1.f / (1.f + __expf(l1 - l0)); }
    }
    __syncthreads();
    LAS unsigned char* tile = F.lds + F.wave * 16384;
    const int gw = F.vcu * NWAVES + F.wave, NGW = F.G * NWAVES;
    bf16_t* WIN = (bf16_t*)(F.ws + WS_WIN); bf16_t* WA = (bf16_t*)(F.ws + WS_WA); bf16_t* WB = (bf16_t*)(F.ws + WS_WB); bf16_t* WO = (bf16_t*)(F.ws + WS_WO);
    for (int it = gw; it < 1920; it += NGW) {
        int r = it; f32x4 v[16];
        if (r < 1408) { const int kb = r / 88, nb = r % 88;
            if (nb >= 56) { e8_load(v, F.in[I_WIN] + (size_t)(kb * 64) * INC + nb * 64, INC, F.lane); e8_store(v, F.ws + WS_W8 + (size_t)((nb - 56) * 64) * D + kb * 64, D, F.lane); continue; }
            t64_load(v, F.in[I_WIN] + (size_t)(kb * 64) * INC + nb * 64, INC, F.lane); t64_store(v, WIN + (size_t)(nb * 64) * D + kb * 64, D, tile, F.lane); continue; } r -= 1408;
        if (r < 128) { const int kb = r / 16, nb = r % 16; t64_load(v, F.in[I_WBA] + (size_t)(kb * 64) * D + nb * 64, D, F.lane); t64_store(v, WA + (size_t)(nb * 64) * D + kb * 64, D, tile, F.lane); continue; } r -= 128;
        if (r < 128) { const int kb = r / 16, nb = r % 16; t64_load(v, F.in[I_WBB] + (size_t)(kb * 64) * D + nb * 64, D, F.lane); t64_store(v, WA + (size_t)(nb * 64) * D + 512 + kb * 64, D, tile, F.lane); continue; } r -= 128;
        { const int kb = r / 16, nb = r % 16; t64_load(v, F.in[I_WOUT] + (size_t)(kb * 64) * D + nb * 64, D, F.lane); t64_store(v, WO + (size_t)(nb * 64) * D + kb * 64, D, tile, F.lane); }
    }
}

__device__ __forceinline__ void ph_norm1(Frame& F) {
    const float* MOD = (const float*)(F.ws + WS_MOD); bf16_t* H = (bf16_t*)(F.ws + WS_H); unsigned char* H8 = F.ws + WS_H8;
    const int gw = F.vcu * NWAVES + F.wave, NGW = F.G * NWAVES;
    int curb = -1; f32x4 ca[4], cb[4];
    for (int m = gw; m < MT; m += NGW) {
        const int b = m < ML ? m / T : 4;
        if (b != curb) { curb = b;
#pragma unroll
            for (int j = 0; j < 4; ++j) { const int col = 4 * F.lane + 256 * j; const f32x4 w4 = *(const f32x4*)(F.in[I_NMIX] + col), s4 = *(const f32x4*)(MOD + b * (NMOD * D) + D + col);
                ca[j] = w4 * (s4 + 1.f); cb[j] = *(const f32x4*)(MOD + b * (NMOD * D) + col); } }
        const float* xr = m < ML ? F.in[I_X] + (size_t)m * D : F.in[I_CTX] + (size_t)(m - ML) * D;
        f32x4 v[4]; float ss = 0.f;
#pragma unroll
        for (int j = 0; j < 4; ++j) { v[j] = __builtin_nontemporal_load((const f32x4*)(xr + 4 * F.lane + 256 * j)); ss += (v[j].x * v[j].x + v[j].y * v[j].y) + (v[j].z * v[j].z + v[j].w * v[j].w); }
        const float rstd = rsqrtf(wave_sum(ss) * (1.f / D) + EPS);
#pragma unroll
        for (int j = 0; j < 4; ++j) { const f32x4 o = v[j] * rstd * ca[j] + cb[j]; u32x2 w; w.x = pk2(o.x, o.y); w.y = pk2(o.z, o.w);
            *(u32x2*)(H + (size_t)m * D + 4 * F.lane + 256 * j) = w;
            if (m < ML) *(unsigned*)(H8 + (size_t)m * D + 4 * F.lane + 256 * j) = pk4_f8(o.x * SC_H8, o.y * SC_H8, o.z * SC_H8, o.w * SC_H8); }
    }
}

namespace hg {
constexpr int TS = 136, TILE_B = 64 * TS * 2;
constexpr int OFF_QT = 0, OFF_KT = TILE_B, OFF_VT = 2 * TILE_B, OFF_EM = 3 * TILE_B, OFF_D2 = OFF_EM + 512, BUF_B = 3 * TILE_B + 1024;
constexpr int PS = 72, OFF_P = 2 * BUF_B, OFF_TOT = OFF_P + 64 * PS * 2;
static_assert(OFF_TOT + 2048 <= RING_BYTES, "hg LDS map");
typedef short v4i16_t __attribute__((ext_vector_type(4)));
__device__ __forceinline__ v4i16_t trd(const LAS unsigned char* p) { return __builtin_amdgcn_ds_read_tr16_b64_v4i16((LAS v4i16_t*)p); }
__device__ __forceinline__ bf16x8 cat8(v4i16_t lo, v4i16_t hi) { return (bf16x8){lo[0], lo[1], lo[2], lo[3], hi[0], hi[1], hi[2], hi[3]}; }
#define HG_BAR_LDS() do { asm volatile("s_waitcnt lgkmcnt(0)" ::: "memory"); __builtin_amdgcn_s_barrier(); asm volatile("" ::: "memory"); } while (0)
struct Raw { unsigned lf[16], q[16]; u32x4 v[4]; };
struct PSt { int unused; };

template <bool OUT>
__device__ __forceinline__ void load_raw(Frame& F, Raw& R, const bf16_t* Qb, const bf16_t* Fb, const bf16_t* Vb, int rowbase, int len, int dir, int p0, int h, int pw) {
    asm volatile("" : "+v"(p0));
#pragma unroll
    for (int i = 0; i < 16; ++i) { const int p = p0 + 16 * pw + i, tok = dir ? len - 1 - p : p; const size_t off = (size_t)(rowbase + tok) * HW + h * DK + 2 * F.lane;
        R.lf[i] = *(const unsigned*)(Fb + off); if (OUT) R.q[i] = *(const unsigned*)(Qb + off); }
    { const int pt = F.lane + 64 * pw, r = pt >> 2, qd = pt & 3, p = p0 + r, tok = dir ? len - 1 - p : p; const bf16_t* vp = Vb + (size_t)(rowbase + tok) * HW + h * DK + qd * 32;
#pragma unroll
      for (int x = 0; x < 4; ++x) R.v[x] = *(const u32x4*)(vp + 8 * x); }
}
__device__ __forceinline__ void prep1(Frame& F, const Raw& R, LAS unsigned char* buf, int pw, PSt& P) {
    LAS float* TOT = (LAS float*)(F.lds + OFF_TOT);
    float a0 = 0.f, a1 = 0.f;
#pragma unroll
    for (int i = 0; i < 16; ++i) { a0 += bflo(R.lf[i]); a1 += bfhi(R.lf[i]); }
    *(LAS f32x2*)(TOT + pw * 128 + 2 * F.lane) = (f32x2){a0, a1};
    { const int pt = F.lane + 64 * pw, r = pt >> 2, qd = pt & 3;
#pragma unroll
      for (int x = 0; x < 4; ++x) *(LAS u32x4*)(buf + OFF_VT + (r * TS + qd * 32 + 8 * x) * 2) = R.v[x]; }
}
template <bool OUT>
__device__ __forceinline__ void prep2(Frame& F, const Raw& R, LAS unsigned char* buf, int pw, const PSt& P, float& seg0, float& seg1) {
    const LAS float* TOT = (const LAS float*)(F.lds + OFF_TOT);
    float off0 = 0.f, off1 = 0.f, m0 = 0.f, m1 = 0.f, t0 = 0.f, t1 = 0.f, own0 = 0.f, own1 = 0.f;
#pragma unroll
    for (int g2 = 0; g2 < 4; ++g2) { const f32x2 t = *(const LAS f32x2*)(TOT + g2 * 128 + 2 * F.lane);
        if (g2 < pw) { off0 += t.x; off1 += t.y; } if (g2 == pw) { own0 = t.x; own1 = t.y; } if (g2 < 2) { m0 += t.x; m1 += t.y; } t0 += t.x; t1 += t.y; }
    float f0[16], f1[16];
    float E0 = __expf(fminf(off0 - m0, 80.f)), E1 = __expf(fminf(off1 - m1, 80.f));
#pragma unroll
    for (int i = 0; i < 16; ++i) { f0[i] = __expf(bflo(R.lf[i])); f1[i] = __expf(bfhi(R.lf[i])); E0 *= f0[i]; E1 *= f1[i];
        if (OUT) *(LAS unsigned*)(buf + OFF_QT + ((16 * pw + i) * TS + 2 * F.lane) * 2) = cvt_pk_bf16(bflo(R.q[i]) * E0, bfhi(R.q[i]) * E1); }
    float G0 = __expf(fminf(m0 - (off0 + own0), 80.f)), G1 = __expf(fminf(m1 - (off1 + own1), 80.f));
#pragma unroll
    for (int i = 15; i >= 0; --i) { *(LAS unsigned*)(buf + OFF_KT + ((16 * pw + i) * TS + 2 * F.lane) * 2) = cvt_pk_bf16((1.f - f0[i]) * G0, (1.f - f1[i]) * G1); G0 *= f0[i]; G1 *= f1[i]; }
    if (pw == 0) { *(LAS f32x2*)(buf + OFF_EM + 8 * F.lane) = (f32x2){__expf(m0), __expf(m1)}; *(LAS f32x2*)(buf + OFF_D2 + 8 * F.lane) = (f32x2){__expf(t0 - m0), __expf(t1 - m1)}; }
    seg0 += t0; seg1 += t1;
}
__device__ __forceinline__ void p_tile(Frame& F, const LAS unsigned char* buf, int it, int jt) {
    const int c = F.lane & 15, g = F.lane >> 4;
    f32x4 acc = (f32x4){0.f, 0.f, 0.f, 0.f};
    bf16x8 a[4], b[4];
#pragma unroll
    for (int s = 0; s < 4; ++s) { a[s] = *(const LAS bf16x8*)(buf + OFF_KT + ((16 * jt + c) * TS + 32 * s + 8 * g) * 2); b[s] = *(const LAS bf16x8*)(buf + OFF_QT + ((16 * it + c) * TS + 32 * s + 8 * g) * 2); }
#pragma unroll
    for (int s = 0; s < 4; ++s) acc = __builtin_amdgcn_mfma_f32_16x16x32_bf16(a[s], b[s], acc, 0, 0, 0);
    if (it == jt) {
#pragma unroll
        for (int r = 0; r < 4; ++r) acc[r] = (4 * g + r > c) ? 0.f : acc[r]; }
    u32x2 wv; wv.x = cvt_pk_bf16(acc[0], acc[1]); wv.y = cvt_pk_bf16(acc[2], acc[3]);
    *(LAS u32x2*)(F.lds + OFF_P + ((16 * it + c) * PS + 16 * jt + 4 * g) * 2) = wv;
}
__device__ __forceinline__ void tile_of(int idx, int& it, int& jt) { it = (idx >= 6) ? 3 : (idx >= 3) ? 2 : (idx >= 1) ? 1 : 0; jt = idx - it * (it + 1) / 2; }
__device__ __forceinline__ void m_part1(Frame& F, const LAS unsigned char* buf, int mw, f32x4 (&S)[2][8], f32x4 (&oT)[2][4], bf16x8 (&vf)[2][2]) {
    const int c = F.lane & 15, g = F.lane >> 4;
    { int it, jt; tile_of(mw, it, jt); p_tile(F, buf, it, jt); asm volatile("" ::: "memory"); tile_of(mw + 4, it, jt); p_tile(F, buf, it, jt); asm volatile("" ::: "memory"); if (mw < 2) { tile_of(mw + 8, it, jt); p_tile(F, buf, it, jt); } asm volatile("" ::: "memory"); }
#pragma unroll
    for (int vs = 0; vs < 2; ++vs)
#pragma unroll
        for (int it = 0; it < 4; ++it) oT[vs][it] = (f32x4){0.f, 0.f, 0.f, 0.f};
#pragma unroll
    for (int s = 0; s < 4; ++s) {
        bf16x8 af[2], bq[4];
#pragma unroll
        for (int it = 0; it < 4; ++it) { const LAS unsigned char* qp = buf + OFF_QT + ((16 * it + c) * TS + 32 * s + 4 * g) * 2;
            const u32x2 lo = *(const LAS u32x2*)qp, hi = *(const LAS u32x2*)(qp + 32); bq[it] = __builtin_bit_cast(bf16x8, (u32x4){lo.x, lo.y, hi.x, hi.y}); }
#pragma unroll
        for (int vs = 0; vs < 2; ++vs) { u32x4 aw; aw.x = cvt_pk_bf16(S[vs][2 * s][0], S[vs][2 * s][1]); aw.y = cvt_pk_bf16(S[vs][2 * s][2], S[vs][2 * s][3]); aw.z = cvt_pk_bf16(S[vs][2 * s + 1][0], S[vs][2 * s + 1][1]); aw.w = cvt_pk_bf16(S[vs][2 * s + 1][2], S[vs][2 * s + 1][3]);
            af[vs] = __builtin_bit_cast(bf16x8, aw); }
#pragma unroll
        for (int it = 0; it < 4; ++it) {
            oT[0][it] = __builtin_amdgcn_mfma_f32_16x16x32_bf16(af[0], bq[it], oT[0][it], 0, 0, 0);
            oT[1][it] = __builtin_amdgcn_mfma_f32_16x16x32_bf16(af[1], bq[it], oT[1][it], 0, 0, 0); }
        asm volatile("" ::: "memory");
    }
    const int trow = 8 * g + (c >> 2), tcol = 4 * (c & 3);
#pragma unroll
    for (int vs = 0; vs < 2; ++vs)
#pragma unroll
        for (int js = 0; js < 2; ++js) { const LAS unsigned char* vp = buf + OFF_VT + ((32 * js + trow) * TS + 32 * mw + 16 * vs + tcol) * 2; vf[vs][js] = cat8(trd(vp), trd(vp + 4 * TS * 2)); }
    { bf16x8 kf[8];
#pragma unroll
      for (int t = 0; t < 8; ++t) { const LAS unsigned char* kp = buf + OFF_KT + (trow * TS + 16 * t + tcol) * 2; kf[t] = cat8(trd(kp), trd(kp + 4 * TS * 2)); }
#pragma unroll
      for (int t = 0; t < 8; ++t) {
          S[0][t] = __builtin_amdgcn_mfma_f32_16x16x32_bf16(kf[t], vf[0][0], S[0][t], 0, 0, 0);
          S[1][t] = __builtin_amdgcn_mfma_f32_16x16x32_bf16(kf[t], vf[1][0], S[1][t], 0, 0, 0); } }
}
template <bool OUT>
__device__ __forceinline__ void m_part2(Frame& F, const LAS unsigned char* buf, int mw, f32x4 (&S)[2][8], f32x4 (&oT)[2][4], bf16x8 (&vf)[2][2]) {
    const int c = F.lane & 15, g = F.lane >> 4;
    const int trow = 8 * g + (c >> 2), tcol = 4 * (c & 3);
    if (!OUT) {
#pragma unroll
        for (int vs = 0; vs < 2; ++vs)
#pragma unroll
            for (int js = 0; js < 2; ++js) { const LAS unsigned char* vp = buf + OFF_VT + ((32 * js + trow) * TS + 32 * mw + 16 * vs + tcol) * 2; vf[vs][js] = cat8(trd(vp), trd(vp + 4 * TS * 2)); }
    }
    if (OUT) {
        bf16x8 pb[4][2];
#pragma unroll
        for (int it = 0; it < 4; ++it)
#pragma unroll
            for (int js = 0; js < 2; ++js) if (32 * js <= 16 * it + 15) pb[it][js] = *(const LAS bf16x8*)(F.lds + OFF_P + ((16 * it + c) * PS + 32 * js + 8 * g) * 2);
#pragma unroll
        for (int it = 0; it < 4; ++it)
#pragma unroll
            for (int js = 0; js < 2; ++js) if (32 * js <= 16 * it + 15) {
                oT[0][it] = __builtin_amdgcn_mfma_f32_16x16x32_bf16(vf[0][js], pb[it][js], oT[0][it], 0, 0, 0);
                oT[1][it] = __builtin_amdgcn_mfma_f32_16x16x32_bf16(vf[1][js], pb[it][js], oT[1][it], 0, 0, 0); }
    }
    constexpr int TB = 8;
#pragma unroll
    for (int js = OUT ? 1 : 0; js < 2; ++js)
#pragma unroll
        for (int t0 = 0; t0 < 8; t0 += TB) {
            bf16x8 kf[TB];
#pragma unroll
            for (int t = 0; t < TB; ++t) { const LAS unsigned char* kp = buf + OFF_KT + ((32 * js + trow) * TS + 16 * (t0 + t) + tcol) * 2; kf[t] = cat8(trd(kp), trd(kp + 4 * TS * 2)); }
#pragma unroll
            for (int t = 0; t < TB; ++t) {
                S[0][t0 + t] = __builtin_amdgcn_mfma_f32_16x16x32_bf16(kf[t], vf[0][js], S[0][t0 + t], 0, 0, 0);
                S[1][t0 + t] = __builtin_amdgcn_mfma_f32_16x16x32_bf16(kf[t], vf[1][js], S[1][t0 + t], 0, 0, 0); }
            asm volatile("" ::: "memory");
        }
}
__device__ __forceinline__ void m_scale(Frame& F, const LAS unsigned char* buf, const LAS unsigned char* bufprev, bool hasprev, f32x4 (&S)[2][8]) {
    const int g = F.lane >> 4;
    f32x4 e4[8];
#pragma unroll
    for (int t = 0; t < 8; ++t) e4[t] = *(const LAS f32x4*)(buf + OFF_EM + (16 * t + 4 * g) * 4);
    if (hasprev) {
#pragma unroll
        for (int t = 0; t < 8; ++t) e4[t] *= *(const LAS f32x4*)(bufprev + OFF_D2 + (16 * t + 4 * g) * 4); }
#pragma unroll
    for (int t = 0; t < 8; ++t) { S[0][t] *= e4[t]; S[1][t] *= e4[t]; }
}
__device__ __forceinline__ void m_final_scale(Frame& F, const LAS unsigned char* buf, f32x4 (&S)[2][8]) {
    const int g = F.lane >> 4;
#pragma unroll
    for (int t = 0; t < 8; ++t) { const f32x4 d4 = *(const LAS f32x4*)(buf + OFF_D2 + (16 * t + 4 * g) * 4); S[0][t] *= d4; S[1][t] *= d4; }
}
__device__ __forceinline__ size_t st_idx(int mw, int vs, int t, int lane) { return (size_t)((((mw * 2 + vs) * 8 + t) * 64 + lane) * 4); }

struct ConvSt { f32x4 v[16]; unsigned char* dst; int ld; int have; };
__device__ __forceinline__ void conv_issue(Frame& F, ConvSt& C, int idx) {
    C.have = (idx >= 0 && idx < 8192) ? 1 : 0;
    if (C.have) { const float* src; int ls; econv_addr(F, 16384 + idx, src, ls, C.dst, C.ld); e8_load(C.v, src, ls, F.lane); }
}
__device__ __forceinline__ void conv_finish(Frame& F, ConvSt& C) { if (C.have) { e8_store(C.v, C.dst, C.ld, F.lane); C.have = 0; } }
template <bool OUT>
__device__ __forceinline__ void scan_item(Frame& F, int item) {
    const int seq = item >> 3, part = item & 7, b = seq >> 3, h = (seq >> 1) & 3, dir = seq & 1;
    const bool isctx = !OUT && part == 0;
    const int len = isctx ? CTXL : T, rowbase = isctx ? ML + b * CTXL : b * T, nch = isctx ? 4 : 16, pbeg = OUT ? part * 1024 : (isctx ? 0 : (part - 1) * 1024);
    const bf16_t* Qb = (const bf16_t*)(F.ws + WS_Q); const bf16_t* Fb = (const bf16_t*)(F.ws + (dir ? WS_FB : WS_FF)); const bf16_t* Vb = (const bf16_t*)(F.ws + WS_V);
    bf16_t* OD = (bf16_t*)(F.ws + WS_ODIR) + (size_t)dir * ML * HW;
    const bool isP = F.wave >= 4; const int pw = F.wave & 3, mw = F.wave & 3;
    const int c = F.lane & 15, g = F.lane >> 4;
    f32x4 S[2][8], oT[2][4];
    Raw RA, RB; PSt PS_;
    float seg0 = 0.f, seg1 = 0.f;
    if (isP) { load_raw<OUT>(F, RA, Qb, Fb, Vb, rowbase, len, dir, pbeg, h, pw); }
    else {
        if (OUT) {
            const float* ST = (const float*)(F.ws + WS_STATE) + (size_t)(seq * 8 + part) * 16384;
#pragma unroll
            for (int vs = 0; vs < 2; ++vs)
#pragma unroll
                for (int t = 0; t < 8; ++t) S[vs][t] = *(const f32x4*)(ST + st_idx(mw, vs, t, F.lane));
            { const int half = F.tid >> 7, q = F.tid & 127, row = (half ? 32 : 0) + (q >> 3), col = (half ? 48 : 16) + 2 * (q & 7); *(LAS unsigned*)(F.lds + OFF_P + (row * PS + col) * 2) = 0u; }
        } else {
#pragma unroll
            for (int vs = 0; vs < 2; ++vs)
#pragma unroll
                for (int t = 0; t < 8; ++t) S[vs][t] = (f32x4){0.f, 0.f, 0.f, 0.f};
        }
    }
    if (isP) {
#define HG_P_PERIOD(RCUR, RNXT, n_) do { const int pn_ = (n_); LAS unsigned char* bufp = F.lds + (pn_ & 1) * BUF_B; \
            if (pn_ + 1 < nch) load_raw<OUT>(F, RNXT, Qb, Fb, Vb, rowbase, len, dir, pbeg + 64 * (pn_ + 1), h, pw); \
            if (pn_ < nch) prep1(F, RCUR, bufp, pw, PS_); \
            HG_BAR_LDS(); \
            if (pn_ < nch) prep2<OUT>(F, RCUR, bufp, pw, PS_, seg0, seg1); \
            HG_BAR_LDS(); } while (0)
        for (int n = 0; n <= nch; n += 2) { HG_P_PERIOD(RA, RB, n); if (n + 1 <= nch) HG_P_PERIOD(RB, RA, n + 1); }
#undef HG_P_PERIOD
    } else {
        ConvSt CV; CV.have = 0; CV.dst = nullptr; CV.ld = 0; bf16x8 vfm[2][2];
        for (int n = 0; n <= nch; ++n) {
            const LAS unsigned char* bufm = F.lds + ((n - 1) & 1) * BUF_B;
            if (!OUT) { conv_finish(F, CV); conv_issue(F, CV, (!isctx && (n & 1) && n < 16) ? ((seq * 7 + part - 1) * 4 + mw) * 8 + (n >> 1) : -1); }
            if (n >= 1) m_scale(F, bufm, F.lds + (n & 1) * BUF_B, n >= 2, S);
            if (OUT && n >= 1) m_part1(F, bufm, mw, S, oT, vfm);
            HG_BAR_LDS();
            if (n >= 1) { m_part2<OUT>(F, bufm, mw, S, oT, vfm);
                if (OUT) {
#pragma unroll
                    for (int vs = 0; vs < 2; ++vs)
#pragma unroll
                        for (int it = 0; it < 4; ++it) { const int p = pbeg + 64 * (n - 1) + 16 * it + c, tok = dir ? T - 1 - p : p;
                            u32x2 wv; wv.x = cvt_pk_bf16(oT[vs][it][0], oT[vs][it][1]); wv.y = cvt_pk_bf16(oT[vs][it][2], oT[vs][it][3]);
                            *(u32x2*)(OD + (size_t)(rowbase + tok) * HW + h * DK + 32 * mw + 16 * vs + 4 * g) = wv; } } }
            HG_BAR_LDS();
        }
        if (!OUT) { conv_finish(F, CV); m_final_scale(F, F.lds + ((nch - 1) & 1) * BUF_B, S); }
    }
    if (!OUT) {
        float* ST = (float*)(F.ws + WS_STATE) + (size_t)item * 16384; float* DC = (float*)(F.ws + WS_DEC) + item * 128;
        if (!isP) {
#pragma unroll
            for (int vs = 0; vs < 2; ++vs)
#pragma unroll
                for (int t = 0; t < 8; ++t) *(f32x4*)(ST + st_idx(mw, vs, t, F.lane)) = S[vs][t]; }
        else if (pw == 0) { DC[2 * F.lane] = __expf(seg0); DC[2 * F.lane + 1] = __expf(seg1); }
    }
    HG_BAR_LDS();
}
}

__device__ __forceinline__ void ph_sgu(Frame& F) {
    constexpr int TS = hg::TS; constexpr int OFF_W = 0, OFF_VN = 128 * TS * 2;
    const int g4 = F.bid & 3, c = F.lane & 15, g = F.lane >> 4, w = F.wave;
    const bf16_t* VS = (const bf16_t*)(F.ws + WS_VS); const bf16_t* U = (const bf16_t*)(F.ws + WS_U); bf16_t* AC = (bf16_t*)(F.ws + WS_H);
    { const float* wsrc = F.in[I_SGUW] + (size_t)g4 * 16384;
#pragma unroll
      for (int x = 0; x < 8; ++x) { const int id = F.tid + NTHR * x, row = id >> 5, c4 = id & 31; const f32x4 v = *(const f32x4*)(wsrc + row * 128 + 4 * c4);
          u32x2 o; o.x = pk2(v.x, v.y); o.y = pk2(v.z, v.w); *(LAS u32x2*)(F.lds + OFF_W + (row * TS + 4 * c4) * 2) = o; } }
    float nwr[32]; { const float* nw = F.in[I_SNW] + g4 * 128 + (F.tid & 3) * 32;
#pragma unroll
      for (int e = 0; e < 32; ++e) nwr[e] = nw[e]; }
    const float bs = F.in[I_SGUB][g4 * 128 + 16 * w + c];
    u32x4 vsn[4];
    { const int bn0 = (F.bid >> 2); const int s = F.tid >> 2, part = F.tid & 3; const bf16_t* src = VS + (size_t)((bn0 >> 6) * T + (bn0 & 63) * 128 + s) * SW + g4 * 128 + part * 32;
#pragma unroll
      for (int q = 0; q < 4; ++q) vsn[q] = *(const u32x4*)(src + q * 8); }
    for (int bn = (F.bid >> 2); bn < NB * 64; bn += (F.G >> 2)) {
        const int b = bn >> 6, n = bn & 63, rowbase = b * T + n * 128;
        __syncthreads();
        u32x4 vsc[4];
#pragma unroll
        for (int q = 0; q < 4; ++q) vsc[q] = vsn[q];
        { const int bn1 = bn + (F.G >> 2); if (bn1 < NB * 64) { const int s = F.tid >> 2, part = F.tid & 3; const bf16_t* src = VS + (size_t)((bn1 >> 6) * T + (bn1 & 63) * 128 + s) * SW + g4 * 128 + part * 32;
#pragma unroll
            for (int q = 0; q < 4; ++q) vsn[q] = *(const u32x4*)(src + q * 8); } }
        u32x2 uwp[8];
        { const int t = 16 * w + c;
#pragma unroll
          for (int ct = 0; ct < 8; ++ct) uwp[ct] = *(const u32x2*)(U + (size_t)(rowbase + t) * SW + g4 * 128 + 16 * ct + 4 * g); }
        { const int s = F.tid >> 2, part = F.tid & 3;
          float v[32]; float ss = 0.f;
#pragma unroll
          for (int q = 0; q < 4; ++q) { const u32x4 w4 = vsc[q]; const unsigned ww[4] = {w4.x, w4.y, w4.z, w4.w};
#pragma unroll
              for (int e = 0; e < 4; ++e) { v[q * 8 + 2 * e] = bflo(ww[e]); v[q * 8 + 2 * e + 1] = bfhi(ww[e]); } }
#pragma unroll
          for (int e = 0; e < 32; ++e) ss += v[e] * v[e];
          ss += __shfl_xor(ss, 1); ss += __shfl_xor(ss, 2);
          const float rstd = rsqrtf(ss * (1.f / 128.f) + EPS);
#pragma unroll
          for (int q = 0; q < 4; ++q) { u32x4 o; unsigned ow[4];
#pragma unroll
              for (int e = 0; e < 4; ++e) ow[e] = pk2(v[q * 8 + 2 * e] * rstd * nwr[q * 8 + 2 * e], v[q * 8 + 2 * e + 1] * rstd * nwr[q * 8 + 2 * e + 1]);
              o.x = ow[0]; o.y = ow[1]; o.z = ow[2]; o.w = ow[3];
              *(LAS u32x4*)(F.lds + OFF_VN + (s * TS + part * 32 + q * 8) * 2) = o; } }
        __syncthreads();
        f32x4 acc[8];
#pragma unroll
        for (int ct = 0; ct < 8; ++ct) acc[ct] = (f32x4){0.f, 0.f, 0.f, 0.f};
#pragma unroll
        for (int ks = 0; ks < 4; ++ks) {
            const bf16x8 bw = *(const LAS bf16x8*)(F.lds + OFF_W + ((16 * w + c) * TS + 32 * ks + 8 * g) * 2);
#pragma unroll
            for (int ct = 0; ct < 8; ++ct) { const LAS unsigned char* vp = F.lds + OFF_VN + ((32 * ks + 8 * g + (c >> 2)) * TS + 16 * ct + 4 * (c & 3)) * 2;
                acc[ct] = __builtin_amdgcn_mfma_f32_16x16x32_bf16(hg::cat8(hg::trd(vp), hg::trd(vp + 4 * TS * 2)), bw, acc[ct], 0, 0, 0); }
        }
        const int t = 16 * w + c;
#pragma unroll
        for (int ct = 0; ct < 8; ++ct) { const int col = g4 * 128 + 16 * ct + 4 * g;
            const u32x2 uw = uwp[ct];
            u32x2 o; o.x = pk2(bflo(uw.x) * (acc[ct][0] + bs), bfhi(uw.x) * (acc[ct][1] + bs)); o.y = pk2(bflo(uw.y) * (acc[ct][2] + bs), bfhi(uw.y) * (acc[ct][3] + bs));
            *(u32x2*)(AC + (size_t)(rowbase + t) * D + HW + col) = o; }
    }
    __syncthreads();
}
__device__ __forceinline__ void ph_mix_a(Frame& F) {
    bool did = false;
    for (int it = F.bid; it < 256; it += F.G) if ((it & 7) == 0) { did = true;
        const int seq = it >> 3; SchedCtx S{seq >> 3, (seq >> 1) & 3, seq & 1}; EpiCtx E{F.ws};
        pg8::gemm_phase<EpiCtx, SchedCtx, false>(F.lds, (const bf16_t*)(F.ws + WS_H), D, (const bf16_t*)(F.ws + WS_WIN), D, nullptr, S, E);
    }
    if (did) {
        asm volatile("s_waitcnt vmcnt(0)" ::: "memory"); __syncthreads();
        __builtin_amdgcn_fence(__ATOMIC_ACQUIRE, "agent"); asm volatile("s_waitcnt vmcnt(0)" ::: "memory");
    }
    for (int it = F.bid; it < 256; it += F.G) hg::scan_item<false>(F, it);
    ph_sgu(F);
}
__device__ __forceinline__ void ph_prefix(Frame& F) {
    float* STATE = (float*)(F.ws + WS_STATE); const float* DEC = (const float*)(F.ws + WS_DEC);
    for (int gid = F.bid * NTHR + F.tid; gid < 32 * 4096; gid += F.G * NTHR) {
        const int seq = gid >> 12, q = gid & 4095, t = (q >> 6) & 7, g = (q & 63) >> 4;
        float* st = STATE + (size_t)(seq * 8) * 16384 + 4 * q; const float* dc = DEC + (seq * 8) * 128 + 16 * t + 4 * g;
        f32x4 L[8], Dd[8];
#pragma unroll
        for (int j = 0; j < 8; ++j) { L[j] = *(const f32x4*)(st + (size_t)j * 16384); Dd[j] = *(const f32x4*)(dc + j * 128); }
        f32x4 cacc = L[0];
#pragma unroll
        for (int j = 1; j < 8; ++j) { cacc = Dd[j] * cacc + L[j]; *(f32x4*)(st + (size_t)j * 16384) = cacc; }
    }
}
__device__ __forceinline__ void ph_mix_b(Frame& F) {
    for (int it = F.bid; it < 256; it += F.G) hg::scan_item<true>(F, it);
}

__device__ __forceinline__ void ph_combine(Frame& F) {
    const bf16_t* OD = (const bf16_t*)(F.ws + WS_ODIR); const bf16_t* Gb = (const bf16_t*)(F.ws + WS_G); bf16_t* AC = (bf16_t*)(F.ws + WS_H);
    const int gw = F.vcu * NWAVES + F.wave, NGW = F.G * NWAVES; const int c0 = 8 * F.lane;
    float nw[8];
#pragma unroll
    for (int e = 0; e < 8; ++e) nw[e] = F.in[I_HNW][c0 + e];
#define CB_LOAD(A_, B_, G_, m_) do { const size_t mm_ = (size_t)(m_); A_ = __builtin_nontemporal_load((const u32x4*)(OD + mm_ * HW + c0)); B_ = __builtin_nontemporal_load((const u32x4*)(OD + (ML + mm_) * HW + c0)); \
        G_ = __builtin_nontemporal_load((const u32x4*)(Gb + mm_ * HW + c0)); } while (0)
#define CB_PASS(A_, B_, G_, AN_, BN_, GN_, m_) do { const int mr_ = (m_); { const int mn_ = (mr_ + NGW < ML) ? mr_ + NGW : mr_; CB_LOAD(AN_, BN_, GN_, mn_); } \
        const unsigned aw[4] = {A_.x, A_.y, A_.z, A_.w}, bw[4] = {B_.x, B_.y, B_.z, B_.w}, gw4[4] = {G_.x, G_.y, G_.z, G_.w}; \
        float o[8]; float ss = 0.f; \
        _Pragma("unroll") for (int e = 0; e < 4; ++e) { o[2 * e] = bflo(aw[e]) + bflo(bw[e]); o[2 * e + 1] = bfhi(aw[e]) + bfhi(bw[e]); ss += o[2 * e] * o[2 * e] + o[2 * e + 1] * o[2 * e + 1]; } \
        ss += __shfl_xor(ss, 1); ss += __shfl_xor(ss, 2); ss += __shfl_xor(ss, 4); ss += __shfl_xor(ss, 8); \
        const float rstd = rsqrtf(ss * (1.f / 128.f) + EPS); \
        u32x4 w; unsigned ww[4]; \
        _Pragma("unroll") for (int e = 0; e < 4; ++e) ww[e] = pk2(o[2 * e] * rstd * nw[2 * e] * bflo(gw4[e]), o[2 * e + 1] * rstd * nw[2 * e + 1] * bfhi(gw4[e])); \
        w.x = ww[0]; w.y = ww[1]; w.z = ww[2]; w.w = ww[3]; \
        *(u32x4*)(AC + (size_t)mr_ * D + c0) = w; } while (0)
    u32x4 a0, b0, g0, a1, b1, g1;
    CB_LOAD(a0, b0, g0, gw);
    for (int m = gw; m < ML; m += 2 * NGW) { CB_PASS(a0, b0, g0, a1, b1, g1, m); if (m + NGW < ML) CB_PASS(a1, b1, g1, a0, b0, g0, m + NGW); }
#undef CB_LOAD
#undef CB_PASS
}

__device__ __forceinline__ void ph_norm2(Frame& F) {
    const float* MOD = (const float*)(F.ws + WS_MOD); unsigned char* H2 = F.ws + WS_H; float* AFF = (float*)(F.ws + WS_AFF);
    LAS float* rwl = (LAS float*)F.lds;
    LAS float* cab = (LAS float*)(F.lds + 81920);
    { f32x4 w[8]; const float* rwg = F.in[I_RW];
#pragma unroll
        for (int u = 0; u < 8; ++u) w[u] = *(const f32x4*)(rwg + 4 * (F.tid + NTHR * u));
#pragma unroll
        for (int u = 0; u < 8; ++u) { const int idx = 4 * (F.tid + NTHR * u), k = idx >> 4, n = idx & 15; LAS float* p = rwl + (((k >> 6) * 4 + ((k >> 4) & 3)) * 16 + n) * 20 + (k & 15);
            p[0] = w[u].x; p[20] = w[u].y; p[40] = w[u].z; p[60] = w[u].w; }
        f32x4 nw[2], sc[2], sh[2]; const float* nfg = F.in[I_NFFN];
#pragma unroll
        for (int u = 0; u < 2; ++u) { const int idx = 4 * (F.tid + NTHR * u), b = idx >> 10, col = idx & 1023;
            nw[u] = *(const f32x4*)(nfg + col); sc[u] = *(const f32x4*)(MOD + b * (NMOD * D) + 4 * D + col); sh[u] = *(const f32x4*)(MOD + b * (NMOD * D) + 3 * D + col); }
#pragma unroll
        for (int u = 0; u < 2; ++u) { const int idx = 4 * (F.tid + NTHR * u), b = idx >> 10, col = idx & 1023;
            *(LAS f32x4*)(cab + (b * 2) * D + col) = nw[u] * (sc[u] + 1.f); *(LAS f32x4*)(cab + (b * 2 + 1) * D + col) = sh[u]; } }
    __syncthreads();
    const int gw = F.vcu * NWAVES + F.wave, NGW = F.G * NWAVES;
    const int r = F.lane & 15, q = F.lane >> 4;
    for (int tile = gw; tile < ML / 16; tile += NGW) {
        const int R0 = tile * 16, b = R0 / T;
        const bf16_t* xr = (const bf16_t*)F.out + (size_t)(R0 + r) * (2 * D) + 16 * q;
        u32x4 raw[16][2];
#pragma unroll
        for (int i = 0; i < 16; ++i) { raw[i][0] = *(const u32x4*)(xr + 64 * i); raw[i][1] = *(const u32x4*)(xr + 64 * i + 8); }
        float ss = 0.f;
#pragma unroll
        for (int i = 0; i < 16; ++i)
#pragma unroll
            for (int hq = 0; hq < 2; ++hq) { const unsigned ww[4] = {raw[i][hq].x, raw[i][hq].y, raw[i][hq].z, raw[i][hq].w};
#pragma unroll
                for (int e = 0; e < 4; ++e) { const float x0 = bflo(ww[e]), x1 = bfhi(ww[e]); ss += x0 * x0 + x1 * x1; } }
        ss += __shfl_xor(ss, 16); ss += __shfl_xor(ss, 32);
        const float rstd = rsqrtf(ss * (1.f / D) + EPS);
        const LAS float* cap = cab + (b * 2) * D + 16 * q; const LAS float* rwp = rwl + (q * 16 + r) * 20;
        unsigned char* hp = H2 + (size_t)(R0 + r) * D + 16 * q;
        f32x4 acc = {0.f, 0.f, 0.f, 0.f};
        f32x4 can = *(const LAS f32x4*)cap, cbn = *(const LAS f32x4*)(cap + D), wn = *(const LAS f32x4*)rwp;
        u32x4 o8;
#pragma unroll
        for (int g = 0; g < 64; ++g) {
            const int i = g >> 2, c4 = g & 3;
            const f32x4 ca4 = can, cb4 = cbn, w4 = wn;
            if (g + 1 < 64) { const int i1 = (g + 1) >> 2, c1 = (g + 1) & 3;
                can = *(const LAS f32x4*)(cap + 64 * i1 + 4 * c1); cbn = *(const LAS f32x4*)(cap + D + 64 * i1 + 4 * c1); wn = *(const LAS f32x4*)(rwp + i1 * (4 * 16 * 20) + 4 * c1); }
            unsigned r0 = (c4 & 1) ? raw[i][c4 >> 1].z : raw[i][c4 >> 1].x, r1 = (c4 & 1) ? raw[i][c4 >> 1].w : raw[i][c4 >> 1].y;
            asm volatile("" : "+v"(r0), "+v"(r1));
            const f32x4 x4 = {bflo(r0), bfhi(r0), bflo(r1), bfhi(r1)};
            const f32x4 h4 = x4 * rstd * ca4 + cb4;
            o8[c4] = pk4_f8(h4.x * SC_H8, h4.y * SC_H8, h4.z * SC_H8, h4.w * SC_H8);
            acc = __builtin_amdgcn_mfma_f32_16x16x4f32(h4.x, w4.x, acc, 0, 0, 0); acc = __builtin_amdgcn_mfma_f32_16x16x4f32(h4.y, w4.y, acc, 0, 0, 0);
            acc = __builtin_amdgcn_mfma_f32_16x16x4f32(h4.z, w4.z, acc, 0, 0, 0); acc = __builtin_amdgcn_mfma_f32_16x16x4f32(h4.w, w4.w, acc, 0, 0, 0);
            if (c4 == 3) *(u32x4*)(hp + 64 * i) = o8;
            asm volatile("" ::: "memory");
        }
#pragma unroll
        for (int g = 0; g < 4; ++g) {
            float mx = acc[g];
            mx = fmaxf(mx, __shfl_xor(mx, 1)); mx = fmaxf(mx, __shfl_xor(mx, 2)); mx = fmaxf(mx, __shfl_xor(mx, 4)); mx = fmaxf(mx, __shfl_xor(mx, 8));
            const float ex = __expf(acc[g] - mx);
            float den = ex; den += __shfl_xor(den, 1); den += __shfl_xor(den, 2); den += __shfl_xor(den, 4); den += __shfl_xor(den, 8);
            AFF[(size_t)(R0 + 4 * q + g) * NE + r] = ex / den;
        }
    }
}

__device__ __forceinline__ void ph_topk(Frame& F) {
    LAS unsigned* cnt = (LAS unsigned*)F.lds;
    const float* AFF = (const float*)(F.ws + WS_AFF); int* SLOT = (int*)(F.ws + WS_SLOT); int* ROWMAP = (int*)(F.ws + WS_ROWMAP); float* GATE = (float*)(F.ws + WS_GATE);
    for (int item = F.bid; item < NB * NE; item += F.G) {
        const int b = item >> 4, e = item & 15;
        unsigned key[16];
#pragma unroll
        for (int j = 0; j < 16; ++j) key[j] = __builtin_bit_cast(unsigned, AFF[(size_t)(b * T + F.tid * 16 + j) * NE + e]);
        unsigned thr = 0u;
#pragma unroll 1
        for (int bit = 31; bit >= 0; --bit) {
            const unsigned cand = thr | (1u << bit); unsigned c = 0u;
#pragma unroll
            for (int j = 0; j < 16; ++j) c += (key[j] >= cand) ? 1u : 0u;
#pragma unroll
            for (int o = 1; o < 64; o <<= 1) c += __shfl_xor(c, o);
            LAS unsigned* slot = cnt + (bit & 1) * 8;
            if (F.lane == 0) slot[F.wave] = c;
            __syncthreads();
            unsigned tot = 0u;
#pragma unroll
            for (int w = 0; w < 8; ++w) tot += slot[w];
            if (tot >= (unsigned)CAP) thr = cand;
        }
        unsigned cg = 0u, ce = 0u;
#pragma unroll
        for (int j = 0; j < 16; ++j) { cg += (key[j] > thr) ? 1u : 0u; ce += (key[j] == thr) ? 1u : 0u; }
        unsigned ig = cg, ie = ce;
#pragma unroll
        for (int o = 1; o < 64; o <<= 1) { const unsigned tg = __shfl_up(ig, o), te = __shfl_up(ie, o); if (F.lane >= o) { ig += tg; ie += te; } }
        if (F.lane == 63) { cnt[32 + F.wave] = ig; cnt[40 + F.wave] = ie; }
        __syncthreads();
        unsigned pg = ig - cg, pe = ie - ce, total_gt = 0u;
        for (int w = 0; w < 8; ++w) { const unsigned wg = cnt[32 + w]; total_gt += wg; if (w < F.wave) { pg += wg; pe += cnt[40 + w]; } }
        const unsigned want_eq = CAP - total_gt;
#pragma unroll
        for (int j = 0; j < 16; ++j) { const int i = F.tid * 16 + j; const unsigned k = key[j]; int slot = -1;
            if (k > thr) slot = (int)(pg++);
            else if (k == thr) { const unsigned r = pe++; if (r < want_eq) slot = (int)(total_gt + r); }
            SLOT[(size_t)(b * T + i) * NE + e] = slot;
            if (slot >= 0) { ROWMAP[item * CAP + slot] = b * T + i; GATE[item * CAP + slot] = __builtin_bit_cast(float, k); } }
        __syncthreads();
    }
}

__device__ __forceinline__ void ph_final(Frame& F) {
    const float* MOD = (const float*)(F.ws + WS_MOD); const unsigned char* YE = F.ws + WS_YE; const int* SLOT = (const int*)(F.ws + WS_SLOT);
    const int gw = F.vcu * NWAVES + F.wave, NGW = F.G * NWAVES;
    f32x4 fw[4];
#pragma unroll
    for (int j = 0; j < 4; ++j) fw[j] = *(const f32x4*)(F.in[I_FNW] + 4 * F.lane + 256 * j);
    for (int m = gw; m < ML; m += NGW) {
        const int b = m / T;
        float* xr = F.out + (size_t)m * D;
        f32x4 v[4], mo[4];
#pragma unroll
        for (int j = 0; j < 4; ++j) { const u32x2 w = *(const u32x2*)((const bf16_t*)xr + 4 * F.lane + 256 * j); v[j] = (f32x4){bflo(w.x), bfhi(w.x), bflo(w.y), bfhi(w.y)}; mo[j] = (f32x4){0.f, 0.f, 0.f, 0.f}; }
        const int sl = (F.lane < NE) ? SLOT[(size_t)m * NE + F.lane] : -1;
        f32x4 gfq[4];
#pragma unroll
        for (int j = 0; j < 4; ++j) gfq[j] = *(const f32x4*)(MOD + b * (NMOD * D) + 5 * D + 4 * F.lane + 256 * j);
        unsigned msk = (unsigned)__ballot(sl >= 0) & 0xFFFFu;
        unsigned yv[4][4];
#pragma unroll
        for (int k = 0; k < 4; ++k) { const bool on = msk != 0u; const int e = on ? __builtin_ctz(msk) : 0; msk &= msk - 1u;
            const int s = on ? __builtin_amdgcn_readlane(sl, e) : 0; const unsigned keep = on ? 0xFFFFFFFFu : 0u;
            const unsigned char* yr = YE + ((size_t)(b * NE + e) * CAP + s) * D;
#pragma unroll
            for (int j = 0; j < 4; ++j) yv[k][j] = *(const unsigned*)(yr + 4 * F.lane + 256 * j) & keep; }
#pragma unroll
        for (int k = 0; k < 4; ++k)
#pragma unroll
            for (int j = 0; j < 4; ++j) mo[j] += f8x4_f32(yv[k][j]);
        while (msk) { const int e = __builtin_ctz(msk); msk &= msk - 1u; const int s = __builtin_amdgcn_readlane(sl, e);
            const unsigned char* yr = YE + ((size_t)(b * NE + e) * CAP + s) * D;
#pragma unroll
            for (int j = 0; j < 4; ++j) mo[j] += f8x4_f32(*(const unsigned*)(yr + 4 * F.lane + 256 * j)); }
        float ss = 0.f;
#pragma unroll
        for (int j = 0; j < 4; ++j) { const f32x4 gf = gfq[j] * (1.f / SC_YE8); v[j] += gf * mo[j]; ss += (v[j].x * v[j].x + v[j].y * v[j].y) + (v[j].z * v[j].z + v[j].w * v[j].w); }
        const float rstd = rsqrtf(wave_sum(ss) * (1.f / D) + EPS);
#pragma unroll
        for (int j = 0; j < 4; ++j) *(f32x4*)(xr + 4 * F.lane + 256 * j) = v[j] * rstd * fw[j];
    }
}

constexpr int N_PHASES = 14;
#ifndef SCHED_GR
#define SCHED_GR 2
#endif
__global__ void __launch_bounds__(NTHR, 2) skel_fwd(Args args) {
    extern __shared__ __attribute__((aligned(16))) unsigned char lds_raw[];
    Frame F;
    F.lds = (LAS unsigned char*)lds_raw;
    F.tid = threadIdx.x; F.lane = F.tid & 63; F.wave = __builtin_amdgcn_readfirstlane(F.tid >> 6);
    F.G = gridDim.x; F.bid = blockIdx.x; F.vcu = (F.G % 8 == 0) ? (F.bid % 8) * (F.G / 8) + F.bid / 8 : F.bid;
    F.out = args.out; F.ws = args.ws;
    volatile LAS unsigned* MISC = (volatile LAS unsigned*)(F.lds + MISC_OFF);
    for (int u = F.tid; u < (LDS_BYTES - LDSCTL_OFF) / 4; u += NTHR) ((LAS unsigned*)(F.lds + LDSCTL_OFF))[u] = 0u;
    __syncthreads();
    XcdBarrier bar; bar.bar = (unsigned*)(F.ws + WS_CTL) + CW_BAR; bar.x = 0; bar.st = nullptr;
#if !MK_PER_PHASE
    bar = xcd_barrier_post((unsigned*)(F.ws + WS_CTL) + CW_BAR, MISC + 8);
#endif
    const int lo = args.ph_lo, hi = args.ph_hi;
#ifndef PH_MASK
#define PH_MASK 0x3fff
#endif
#define IN(k) (((PH_MASK >> (k)) & 1) && lo <= (k) && (k) < hi)
#define SEAM(k) do { if (IN(k) && IN((k) + 1)) xcd_barrier(bar); } while (0)
    if (IN(0)) { ph_prologue(F); } SEAM(0);
    if (IN(1)) { ph_norm1(F); } SEAM(1);
    if (IN(2)) { { SchedIn S; S.init(F.G, F.bid, 14); EpiIn E{F.ws};
            pg8::gemm_phase<EpiIn, SchedIn, false>(F.lds, (const bf16_t*)(F.ws + WS_H), D, (const bf16_t*)(F.ws + WS_WIN), D, nullptr, S, E); }
        { SchedGab S; S.s.init(F.G, F.bid, 8); EpiGab E{F.ws};
            pg8::gemm_phase<EpiGab, SchedGab, false, pg8::NoHook, true>(F.lds, (const bf16_t*)(F.ws + WS_H8), D / 2, (const bf16_t*)(F.ws + WS_W8), D / 2, nullptr, S, E); } } SEAM(2);
    if (IN(3)) { ph_mix_a(F); } SEAM(3);
    if (IN(4)) { ph_prefix(F); } SEAM(4);
    if (IN(5)) { ph_mix_b(F); } SEAM(5);
    if (IN(6)) { ph_combine(F); } SEAM(6);
    if (IN(7)) { StaticOrder S; S.init(128, 4, F.G, F.bid); EpiGate<false> E{(const bf16_t*)(F.ws + WS_GB), nullptr, (bf16_t*)(F.ws + WS_MERGED)}; HookRatio HK{(const bf16_t*)(F.ws + WS_GA)};
        pg8::gemm_phase<EpiGate<false>, StaticOrder, false, HookRatio>(F.lds, (const bf16_t*)(F.ws + WS_H), D, (const bf16_t*)(F.ws + WS_WA), D, nullptr, S, E, HK); } SEAM(7);
    if (IN(8)) { StaticOrder S; S.init(128, 4, F.G, F.bid); EpiX1 E{F.in[I_X], (const float*)(F.ws + WS_MOD), (bf16_t*)F.out};
        pg8::gemm_phase<EpiX1, StaticOrder, false>(F.lds, (const bf16_t*)(F.ws + WS_MERGED), D, (const bf16_t*)(F.ws + WS_WO), D, nullptr, S, E); } SEAM(8);
    if (IN(9)) { ph_norm2(F); } SEAM(9);
    if (IN(10)) { ph_topk(F); econv_queue(F); } SEAM(10);
    if (IN(11)) { SchedMoe1 S{F.G, F.vcu}; EpiHid E{F.ws + WS_HID};
        pg8::gemm_phase<EpiHid, SchedMoe1, true, pg8::NoHook, true>(F.lds, (const bf16_t*)(F.ws + WS_H), D / 2, (const bf16_t*)(F.ws + WS_WGU), D / 2, (const int*)(F.ws + WS_ROWMAP), S, E); } SEAM(11);
    if (IN(12)) { SchedMoe2 S{F.G, F.vcu}; EpiYe E{(const float*)(F.ws + WS_GATE), F.ws + WS_YE};
        pg8::gemm_phase<EpiYe, SchedMoe2, false, pg8::NoHook, true>(F.lds, (const bf16_t*)(F.ws + WS_HID), FF / 2, (const bf16_t*)(F.ws + WS_WD), FF / 2, nullptr, S, E); } SEAM(12);
    if (IN(13)) { ph_final(F); }
#undef IN
#undef SEAM
}

extern "C" void kernel_launch(void* const* d_in, const int* in_sizes, int n_in, void* d_out, int out_size, void* d_ws, size_t ws_size, hipStream_t stream) {
    static int grid = 0;
    if (grid == 0) {
        if (n_in != N_IN || in_sizes[0] != ML * D || out_size != ML * D || ws_size < WS_END) { fprintf(stderr, "kernel_launch: unexpected shapes (n_in %d, in0 %d, out %d, ws %zu < %zu); nothing launched\n", n_in, n_in > 0 ? in_sizes[0] : -1, out_size, ws_size, (size_t)WS_END); grid = -1; return; }
        int dev = 0, cus = 0, per_cu = 0;
        if (hipGetDevice(&dev) != hipSuccess || hipDeviceGetAttribute(&cus, hipDeviceAttributeMultiprocessorCount, dev) != hipSuccess) { grid = -1; return; }
        if (hipFuncSetAttribute((const void*)skel_fwd, hipFuncAttributeMaxDynamicSharedMemorySize, LDS_BYTES) != hipSuccess) { fprintf(stderr, "kernel_launch: hipFuncSetAttribute failed\n"); grid = -1; return; }
        if (hipOccupancyMaxActiveBlocksPerMultiprocessor(&per_cu, (const void*)skel_fwd, NTHR, LDS_BYTES) != hipSuccess || per_cu < 1) fprintf(stderr, "kernel_launch: occupancy query says %d\n", per_cu);
        (void)hipGetLastError();
        grid = cus;
    }
    if (grid < 0) return;
    if (hipMemsetAsync((char*)d_ws + WS_CTL, 0, CTL_ZERO_BYTES, stream) != hipSuccess) return;
    Args a{};
    for (int i = 0; i < N_IN; ++i) a.in[i] = (const float*)d_in[i];
    a.out = (float*)d_out; a.ws = (unsigned char*)d_ws;
#if MK_PER_PHASE
#ifndef DBG_NPH
#define DBG_NPH N_PHASES
#endif
    for (int p = 0; p < DBG_NPH; ++p) { a.ph_lo = p; a.ph_hi = p + 1; hipLaunchKernelGGL(skel_fwd, dim3(grid), dim3(NTHR), LDS_BYTES, stream, a); }
#else
    a.ph_lo = 0; a.ph_hi = N_PHASES; hipLaunchKernelGGL(skel_fwd, dim3(grid), dim3(NTHR), LDS_BYTES, stream, a);
#endif
}
```
